# Optimizing an MI355X kernel written in HIP

```python
import math
import jax, jax.numpy as jnp
from jax import lax
import numpy as np

D_MODEL = 1024
BATCH = 8
SEQ = 4096
DEPTH = 2

N_MIXERS = 2
N_ATTN_LAYERS = (DEPTH + 1) // 2
N_HGRN_LAYERS = DEPTH // 2

ATT_HEADS = 16
ATT_HEAD_DIM = 64
ATT_KV_HEADS = 2
Q_LORA_RANK = 256
IDX_HEADS = 8
IDX_DIM = 128
INDEX_TOPK = 256
Q_BLOCK = 128
ATT_KV_DIM = ATT_KV_HEADS * ATT_HEAD_DIM
ATT_IN_DIM = Q_LORA_RANK + 2 * ATT_KV_DIM + IDX_DIM + IDX_HEADS

HGRN_EXPAND = 128
HGRN_HEADS = D_MODEL // HGRN_EXPAND
HGRN_F_DIM = HGRN_HEADS * HGRN_EXPAND
HGRN_V_DIM = D_MODEL // HGRN_HEADS
HGRN_CHUNK = 64
HGRN_IN_DIM = 2 * HGRN_F_DIM + D_MODEL + D_MODEL

D_FF = -(-8 * D_MODEL // (3 * 256)) * 256

ROPE_THETA = 500000.0
ATT_ROT_DIM = ATT_HEAD_DIM // 4
IDX_ROT_DIM = IDX_DIM // 4
DEEPNORM_ALPHA = (2 * DEPTH) ** 0.25
DEEPNORM_BETA = (8 * DEPTH) ** -0.25
LN_EPS = 1e-5
RMS_EPS = 1e-6

kernel_name = "dsa_hgrn2_interleaved_deepnorm"


def layer_norm(x, g, b):
    xf = x.astype(jnp.float32)
    mu = jnp.mean(xf, axis=-1, keepdims=True)
    var = jnp.mean(jnp.square(xf - mu), axis=-1, keepdims=True)
    return ((xf - mu) * lax.rsqrt(var + LN_EPS) * g.astype(jnp.float32) + b.astype(jnp.float32)).astype(x.dtype)


def rms_norm(x, g):
    xf = x.astype(jnp.float32)
    ms = jnp.mean(jnp.square(xf), axis=-1, keepdims=True)
    return (xf * lax.rsqrt(ms + RMS_EPS) * g.astype(jnp.float32)).astype(x.dtype)


def rope_tables(positions, rot_dim):
    inv = ROPE_THETA ** (-jnp.arange(0, rot_dim, 2, dtype=jnp.float32) / rot_dim)
    ang = positions.astype(jnp.float32)[..., None] * inv
    return jnp.cos(ang), jnp.sin(ang)


def apply_rope(x, cos, sin):
    half = cos.shape[-1]
    cos = cos.astype(x.dtype)
    sin = sin.astype(x.dtype)
    x1 = x[..., :half]
    x2 = x[..., half:2 * half]
    return jnp.concatenate([x1 * cos - x2 * sin, x2 * cos + x1 * sin, x[..., 2 * half:]], axis=-1)


def dsa_mixer(x, cos_q, sin_q, cos_i, sin_i, w_in, g_cq, w_uq, w_iq, g_ik, b_ik, w_o):
    B, T, _ = x.shape
    dt = x.dtype
    h = x @ w_in
    c_q, k, v, k_idx, w_idx = jnp.split(
        h, [Q_LORA_RANK, Q_LORA_RANK + ATT_KV_DIM, Q_LORA_RANK + 2 * ATT_KV_DIM,
            Q_LORA_RANK + 2 * ATT_KV_DIM + IDX_DIM], axis=-1)
    c_q = rms_norm(c_q, g_cq)
    q = (c_q @ w_uq).reshape(B, T, ATT_HEADS, ATT_HEAD_DIM)
    q_idx = (c_q @ w_iq).reshape(B, T, IDX_HEADS, IDX_DIM)
    k = k.reshape(B, T, ATT_KV_HEADS, ATT_HEAD_DIM)
    v = v.reshape(B, T, ATT_KV_HEADS, ATT_HEAD_DIM)
    k_idx = layer_norm(k_idx, g_ik, b_ik)
    q = apply_rope(q, cos_q[:, :, None], sin_q[:, :, None])
    k = apply_rope(k, cos_q[:, :, None], sin_q[:, :, None])
    q_idx = apply_rope(q_idx, cos_i[:, :, None], sin_i[:, :, None])
    k_idx = apply_rope(k_idx, cos_i, sin_i)
    w_idx = w_idx * (IDX_HEADS ** -0.5 * IDX_DIM ** -0.5)

    topk = min(INDEX_TOPK, T // 4)
    nb = T // Q_BLOCK
    group = ATT_HEADS // ATT_KV_HEADS
    key_pos = jnp.arange(T)

    def blocks(a):
        return jnp.moveaxis(a.reshape(B, nb, Q_BLOCK, *a.shape[2:]), 1, 0)

    def attend_block(args):
        qb, qib, wb, start = args
        t_pos = start + jnp.arange(Q_BLOCK)
        causal = key_pos[None, :] <= t_pos[:, None]
        rel = jax.nn.relu(jnp.einsum('bqhd,bsd->bhqs', qib, k_idx))
        score = jnp.einsum('bqh,bhqs->bqs', wb, rel).astype(jnp.float32)
        score = jnp.where(causal[None], score, -jnp.inf)
        _, sel = lax.top_k(score, topk)
        valid = sel <= t_pos[None, :, None]
        k_sel = jax.vmap(lambda kk, ii: kk[ii])(k, sel)
        v_sel = jax.vmap(lambda vv, ii: vv[ii])(v, sel)
        qg = qb.reshape(B, Q_BLOCK, ATT_KV_HEADS, group, ATT_HEAD_DIM)
        logits = jnp.einsum('bqgrd,bqkgd->bqgrk', qg, k_sel).astype(jnp.float32) * (ATT_HEAD_DIM ** -0.5)
        logits = jnp.where(valid[:, :, None, None, :], logits, -jnp.inf)
        p = jax.nn.softmax(logits, axis=-1).astype(dt)
        o = jnp.einsum('bqgrk,bqkgd->bqgrd', p, v_sel)
        return o.reshape(B, Q_BLOCK, ATT_HEADS * ATT_HEAD_DIM)

    out = lax.map(attend_block, (blocks(q), blocks(q_idx), blocks(w_idx), jnp.arange(nb) * Q_BLOCK))
    out = jnp.moveaxis(out, 0, 1).reshape(B, T, ATT_HEADS * ATT_HEAD_DIM)
    return out @ w_o


def chunk_gated_linear(q, k, v, logf):
    B, H, T, K = q.shape
    V = v.shape[-1]
    C = HGRN_CHUNK
    nc = T // C
    mask = jnp.tril(jnp.ones((C, C), dtype=bool))

    def to_chunks(a):
        return jnp.moveaxis(a.reshape(B, H, nc, C, a.shape[-1]), 2, 0)

    def step(S, inp):
        qc, kc, vc, gc = inp
        b = jnp.cumsum(gc, axis=-2)
        diff = b[..., :, None, :] - b[..., None, :, :]
        decay = jnp.exp(jnp.where(mask[:, :, None], diff, -jnp.inf))
        attn = jnp.einsum('bhtsk,bhsk->bhts', decay * qc[..., :, None, :], kc)
        o = jnp.einsum('bhts,bhsv->bhtv', attn, vc) + jnp.einsum('bhtk,bhkv->bhtv', qc * jnp.exp(b), S)
        b_last = b[..., -1:, :]
        S = jnp.exp(b_last[..., 0, :])[..., None] * S + jnp.einsum('bhsk,bhsv->bhkv', kc * jnp.exp(b_last - b), vc)
        return S, o

    S0 = jnp.zeros((B, H, K, V), jnp.float32)
    _, o = lax.scan(step, S0, (to_chunks(q), to_chunks(k), to_chunks(v), to_chunks(logf)))
    return jnp.moveaxis(o, 0, 2).reshape(B, H, T, V)


def hgrn2_mixer(x, lb, w_in, g_norm, w_o):
    B, T, _ = x.shape
    dt = x.dtype
    h = x @ w_in
    q, f, i, g = jnp.split(h, [HGRN_F_DIM, 2 * HGRN_F_DIM, 2 * HGRN_F_DIM + D_MODEL], axis=-1)
    q = jax.nn.silu(q.astype(jnp.float32))
    fg = lb + (1.0 - lb) * jax.nn.sigmoid(f.astype(jnp.float32))
    k = 1.0 - fg
    logf = jnp.log(fg)

    def heads(a, d):
        return jnp.transpose(a.reshape(B, T, HGRN_HEADS, d), (0, 2, 1, 3))

    o = chunk_gated_linear(heads(q, HGRN_EXPAND), heads(k, HGRN_EXPAND),
                           heads(i.astype(jnp.float32), HGRN_V_DIM), heads(logf, HGRN_EXPAND))
    o = jnp.transpose(o, (0, 2, 1, 3))
    o = rms_norm(o, g_norm) * jax.nn.silu(g.astype(jnp.float32).reshape(B, T, HGRN_HEADS, HGRN_V_DIM))
    return o.reshape(B, T, D_MODEL).astype(dt) @ w_o


def swiglu(x, w_gate, w_up, w_down):
    return (jax.nn.silu(x @ w_gate) * (x @ w_up)) @ w_down


def setup_inputs(seed: int = 0) -> dict:
    key = jax.random.key(seed)
    ks = jax.random.split(key, 32)
    f32 = jnp.float32
    nA, nB, D = N_ATTN_LAYERS, N_HGRN_LAYERS, D_MODEL

    def nrm(k, shape, fan_in, scale=1.0):
        return jax.random.normal(k, shape, f32) * (fan_in ** -0.5) * scale

    x = jax.random.normal(ks[0], (BATCH, SEQ, D), f32)
    offset = jax.random.randint(ks[1], (BATCH, 1), 0, 1024, dtype=jnp.int32)
    positions = offset + jnp.arange(SEQ, dtype=jnp.int32)[None, :]

    att_w_in = jnp.concatenate([
        nrm(ks[2], (nA, D, Q_LORA_RANK), D),
        nrm(ks[3], (nA, D, ATT_KV_DIM), D),
        nrm(ks[4], (nA, D, ATT_KV_DIM), D, DEEPNORM_BETA),
        nrm(ks[5], (nA, D, IDX_DIM), D),
        nrm(ks[6], (nA, D, IDX_HEADS), D)], axis=-1)
    att_g_cq = 1.0 + 0.02 * jax.random.normal(ks[7], (nA, Q_LORA_RANK), f32)
    att_w_uq = nrm(ks[8], (nA, Q_LORA_RANK, ATT_HEADS * ATT_HEAD_DIM), Q_LORA_RANK)
    att_w_iq = nrm(ks[9], (nA, Q_LORA_RANK, IDX_HEADS * IDX_DIM), Q_LORA_RANK)
    att_g_ik = 1.0 + 0.02 * jax.random.normal(ks[10], (nA, IDX_DIM), f32)
    att_b_ik = 0.02 * jax.random.normal(ks[11], (nA, IDX_DIM), f32)
    att_w_o = nrm(ks[12], (nA, ATT_HEADS * ATT_HEAD_DIM, D), ATT_HEADS * ATT_HEAD_DIM, DEEPNORM_BETA)

    hgrn_lb_logits = 0.5 * jax.random.normal(ks[13], (DEPTH, HGRN_F_DIM), f32)
    hgrn_w_in = jnp.concatenate([
        nrm(ks[14], (nB, D, HGRN_F_DIM), D),
        nrm(ks[15], (nB, D, HGRN_F_DIM), D),
        nrm(ks[16], (nB, D, D), D, DEEPNORM_BETA),
        nrm(ks[17], (nB, D, D), D)], axis=-1)
    hgrn_g_norm = 1.0 + 0.02 * jax.random.normal(ks[18], (nB, HGRN_V_DIM), f32)
    hgrn_w_o = nrm(ks[19], (nB, D, D), D, DEEPNORM_BETA)

    ffn_w_gate = nrm(ks[20], (DEPTH, D, D_FF), D, DEEPNORM_BETA)
    ffn_w_up = nrm(ks[21], (DEPTH, D, D_FF), D, DEEPNORM_BETA)
    ffn_w_down = nrm(ks[22], (DEPTH, D_FF, D), D_FF, DEEPNORM_BETA)

    ln_g = 1.0 + 0.02 * jax.random.normal(ks[23], (DEPTH, 2, D), f32)
    ln_b = 0.02 * jax.random.normal(ks[24], (DEPTH, 2, D), f32)

    return {"x": x, "positions": positions,
            "att_w_in": att_w_in, "att_g_cq": att_g_cq, "att_w_uq": att_w_uq, "att_w_iq": att_w_iq,
            "att_g_ik": att_g_ik, "att_b_ik": att_b_ik, "att_w_o": att_w_o,
            "hgrn_lb_logits": hgrn_lb_logits, "hgrn_w_in": hgrn_w_in, "hgrn_g_norm": hgrn_g_norm,
            "hgrn_w_o": hgrn_w_o,
            "ffn_w_gate": ffn_w_gate, "ffn_w_up": ffn_w_up, "ffn_w_down": ffn_w_down,
            "ln_g": ln_g, "ln_b": ln_b}


def reference(x, positions, att_w_in, att_g_cq, att_w_uq, att_w_iq, att_g_ik, att_b_ik, att_w_o,
              hgrn_lb_logits, hgrn_w_in, hgrn_g_norm, hgrn_w_o,
              ffn_w_gate, ffn_w_up, ffn_w_down, ln_g, ln_b):
    cos_q, sin_q = rope_tables(positions, ATT_ROT_DIM)
    cos_i, sin_i = rope_tables(positions, IDX_ROT_DIM)
    lb_all = jnp.cumsum(jax.nn.softmax(hgrn_lb_logits.astype(jnp.float32), axis=0), axis=0)
    lb_all = lb_all - lb_all[0]
    h = x
    for layer in range(DEPTH):
        j = layer // N_MIXERS
        if layer % N_MIXERS == 0:
            mix = dsa_mixer(h, cos_q, sin_q, cos_i, sin_i, att_w_in[j], att_g_cq[j], att_w_uq[j],
                            att_w_iq[j], att_g_ik[j], att_b_ik[j], att_w_o[j])
        else:
            mix = hgrn2_mixer(h, lb_all[layer], hgrn_w_in[j], hgrn_g_norm[j], hgrn_w_o[j])
        h = layer_norm(DEEPNORM_ALPHA * h + mix, ln_g[layer, 0], ln_b[layer, 0])
        ffn = swiglu(h, ffn_w_gate[layer], ffn_w_up[layer], ffn_w_down[layer])
        h = layer_norm(DEEPNORM_ALPHA * h + ffn, ln_g[layer, 1], ln_b[layer, 1])
    return h
```

```cpp
#include <hip/hip_runtime.h>
#include <cstdio>
#include <cstdint>
namespace pg8 {
#define PG8_LAS __attribute__((address_space(3)))
typedef unsigned short bf16_t;
typedef short bf16x8 __attribute__((ext_vector_type(8)));
typedef float f32x4 __attribute__((ext_vector_type(4)));
typedef unsigned u32x4 __attribute__((ext_vector_type(4)));
constexpr int BM = 256, BK = 64, HALF = 128, HTB = HALF * BK * 2  , STAGE_BYTES = 8 * HTB, NXCD = 8, WGM = 8;

__host__ __device__ __forceinline__ int lds_byte(int r, int c) { const int st = (r >> 4) * 2 + (c >> 5), rr = r & 15, cc = c & 31, ob = rr * 64 + cc * 2; return st * 1024 + (ob ^ (((ob >> 9) & 1) << 5)); }
__host__ __device__ __forceinline__ void stage_rc(int b, int& R, int& C) { const int st = b / 1024, sb = b % 1024, swz = sb ^ (((sb >> 9) & 1) << 5); R = (st >> 1) * 16 + swz / 64; C = (st & 1) * 32 + (swz % 64) / 2; }
__host__ __device__ __forceinline__ int perm32(int rho) { const int n = rho >> 4, i = rho & 15; return 8 * (i >> 2) + 4 * n + (i & 3); }

struct Unit { int pm, pn; };
struct Gemm { const bf16_t* A; const bf16_t* Bt; int M, N, K; };

struct StaticOrder {
    int nM, nN, nwg, G, c;
    __host__ __device__ void init(int M, int N, int G_, int c_) { nM = M / BM; nN = N / BM; nwg = nM * nN; G = G_; c = c_; }
    __host__ __device__ bool next(int i, Unit& u) const {
        const long L = (long)i * G + c; if (L >= nwg) return false;
        int wgid = (int)L; { const int q = nwg / NXCD, r = nwg % NXCD, xcd = wgid % NXCD, off = wgid / NXCD; wgid = (xcd < r ? xcd * (q + 1) : r * (q + 1) + (xcd - r) * q) + off; }
        const int nig = WGM * nN, gid = wgid / nig, fm = gid * WGM, gsz = (nM - fm) < WGM ? (nM - fm) : WGM;
        u.pm = fm + ((wgid % nig) % gsz); u.pn = (wgid % nig) / gsz; return true;
    }
    __device__ __forceinline__ void a_ready(const Unit&) const {}
    __device__ __forceinline__ void done(const Unit&) const {}
};


__device__ __forceinline__ unsigned cvt_pk_bf16(float lo, float hi) { unsigned r; asm volatile("v_cvt_pk_bf16_f32 %0, %1, %2" : "=v"(r) : "v"(lo), "v"(hi)); return r; }
__device__ __forceinline__ float silu_f(float x) { return x * __builtin_amdgcn_rcpf(1.0f + __expf(-x)); }

struct EpiF32 {
    static constexpr bool PERM = false, AFTER_DRAIN = false;
    float* C; int ldc;
    __device__ __forceinline__ void operator()(const f32x4 (&acc)[2][2][4][2], const Unit& u, int wr, int wc, int fr, int fq) const {
        const int row0 = u.pm * BM + wr * 64 + fr, col0 = u.pn * BM + wc * 32 + 4 * fq;
#pragma unroll
        for (int ai = 0; ai < 2; ++ai)
#pragma unroll
            for (int m = 0; m < 4; ++m) { float* rowp = C + (size_t)(row0 + ai * HALF + m * 16) * ldc + col0;
#pragma unroll
                for (int bj = 0; bj < 2; ++bj)
#pragma unroll
                    for (int n = 0; n < 2; ++n) *(f32x4*)(rowp + bj * HALF + n * 16) = acc[ai][bj][m][n]; }
    }
};
struct EpiBf16 {
    static constexpr bool PERM = true, AFTER_DRAIN = false;
    bf16_t* O; int ldc;
    __device__ __forceinline__ void operator()(const f32x4 (&acc)[2][2][4][2], const Unit& u, int wr, int wc, int fr, int fq) const {
        const int row0 = u.pm * BM + wr * 64 + fr, col0 = u.pn * BM + wc * 32 + 8 * fq;
#pragma unroll
        for (int ai = 0; ai < 2; ++ai)
#pragma unroll
            for (int m = 0; m < 4; ++m) { bf16_t* rowp = O + (size_t)(row0 + ai * HALF + m * 16) * ldc + col0;
#pragma unroll
                for (int bj = 0; bj < 2; ++bj) { const f32x4 v0 = acc[ai][bj][m][0], v1 = acc[ai][bj][m][1];
                    u32x4 w; w.x = cvt_pk_bf16(v0[0], v0[1]); w.y = cvt_pk_bf16(v0[2], v0[3]); w.z = cvt_pk_bf16(v1[0], v1[1]); w.w = cvt_pk_bf16(v1[2], v1[3]);
                    *(u32x4*)(rowp + bj * HALF) = w; } }
    }
};
struct EpiRes {
    static constexpr bool PERM = false, AFTER_DRAIN = false;
    const float* base; float* out; int ldc; float alpha;
    __device__ __forceinline__ void operator()(const f32x4 (&acc)[2][2][4][2], const Unit& u, int wr, int wc, int fr, int fq) const {
        const int row0 = u.pm * BM + wr * 64 + fr, col0 = u.pn * BM + wc * 32 + 4 * fq;
#pragma unroll
        for (int ai = 0; ai < 2; ++ai)
#pragma unroll
            for (int m = 0; m < 4; ++m) { const size_t off = (size_t)(row0 + ai * HALF + m * 16) * ldc + col0;
#pragma unroll
                for (int bj = 0; bj < 2; ++bj)
#pragma unroll
                    for (int n = 0; n < 2; ++n) { const f32x4 bs = *(const f32x4*)(base + off + bj * HALF + n * 16); *(f32x4*)(out + off + bj * HALF + n * 16) = bs * alpha + acc[ai][bj][m][n]; }
                if (m & 1) asm volatile("" ::: "memory"); }
    }
};
struct EpiSwiGLU {
    static constexpr bool PERM = true, AFTER_DRAIN = false;
    bf16_t* O; int ldc;
    __device__ __forceinline__ void operator()(const f32x4 (&acc)[2][2][4][2], const Unit& u, int wr, int wc, int fr, int fq) const {
        const int row0 = u.pm * BM + wr * 64 + fr, col0 = u.pn * HALF + wc * 32 + 8 * fq;
#pragma unroll
        for (int ai = 0; ai < 2; ++ai)
#pragma unroll
            for (int m = 0; m < 4; ++m) { bf16_t* rowp = O + (size_t)(row0 + ai * HALF + m * 16) * ldc + col0;
                const f32x4 g0 = acc[ai][0][m][0], g1 = acc[ai][0][m][1], u0 = acc[ai][1][m][0], u1 = acc[ai][1][m][1];
                float r[8];
#pragma unroll
                for (int j = 0; j < 4; ++j) { r[j] = silu_f(g0[j]) * u0[j]; r[4 + j] = silu_f(g1[j]) * u1[j]; }
                u32x4 w; w.x = cvt_pk_bf16(r[0], r[1]); w.y = cvt_pk_bf16(r[2], r[3]); w.z = cvt_pk_bf16(r[4], r[5]); w.w = cvt_pk_bf16(r[6], r[7]);
                *(u32x4*)rowp = w; }
    }
};
struct EpiHgrnIn {
    static constexpr bool PERM = true, AFTER_DRAIN = false;
    bf16_t* O; int ldc; const float* lb;
    __device__ __forceinline__ void operator()(const f32x4 (&acc)[2][2][4][2], const Unit& u, int wr, int wc, int fr, int fq) const {
        const int row0 = u.pm * BM + wr * 64 + fr, col0 = u.pn * BM + wc * 32 + 8 * fq;
        const int type = u.pn >> 2;
        f32x4 lbv[2][2];
#pragma unroll
        for (int bj = 0; bj < 2; ++bj)
#pragma unroll
            for (int n = 0; n < 2; ++n) lbv[bj][n] = *(const f32x4*)(lb + ((col0 + bj * HALF + 4 * n) & 1023));
#pragma unroll
        for (int ai = 0; ai < 2; ++ai)
#pragma unroll
            for (int m = 0; m < 4; ++m) { bf16_t* rowp = O + (size_t)(row0 + ai * HALF + m * 16) * ldc + col0;
#pragma unroll
                for (int bj = 0; bj < 2; ++bj) { f32x4 v[2] = {acc[ai][bj][m][0], acc[ai][bj][m][1]};
#pragma unroll
                    for (int n = 0; n < 2; ++n)
#pragma unroll
                        for (int j = 0; j < 4; ++j) { const float x = v[n][j]; float y = x;
                            if (type == 0 || type == 3) y = silu_f(x);
                            else if (type == 1) { const float l = lbv[bj][n][j]; const float sg = __builtin_amdgcn_rcpf(1.0f + __expf(-x)); y = __logf(l + (1.0f - l) * sg); }
                            v[n][j] = y; }
                    u32x4 w; w.x = cvt_pk_bf16(v[0][0], v[0][1]); w.y = cvt_pk_bf16(v[0][2], v[0][3]); w.z = cvt_pk_bf16(v[1][0], v[1][1]); w.w = cvt_pk_bf16(v[1][2], v[1][3]);
                    *(u32x4*)(rowp + bj * HALF) = w; } }
    }
};


template <class Epi, class Sched, bool ALIGN_EPI = false, bool SP2 = false>
__device__ __forceinline__ void gemm_phase(PG8_LAS unsigned char* lds, const Gemm g, const Sched& S, const Epi& E) {
    const int tid = threadIdx.x, wid = __builtin_amdgcn_readfirstlane(tid >> 6), lane = tid & 63, wr = wid >> 2, wc = wid & 3, fr = lane & 15, fq = lane >> 4;
    const int K = g.K, nt = K / BK;
    unsigned voffA[2], voffB[2];
#pragma unroll
    for (int i = 0; i < 2; ++i) { int R, C; stage_rc(tid * 16 + i * 8192, R, C); const int Rb = Epi::PERM ? ((R & ~31) + perm32(R & 31)) : R;
        voffA[i] = (unsigned)(R * K + C) * 2u; voffB[i] = (unsigned)(Rb * K + C) * 2u; }
    const size_t kstep = (size_t)(BK * 2);
    const size_t hstep = (size_t)HALF * K * 2;
    const size_t tstep = 2 * hstep;
    const unsigned ldsw = (unsigned)wid * 1024u;
    const int aoff = lds_byte(wr * 64 + fr, fq * 8), boff = lds_byte(wc * 32 + fr, fq * 8);
#define PG8_SA(b, h) (((b) * 2 + (h)) * HTB)
#define PG8_SB(b, h) ((4 + (b) * 2 + (h)) * HTB)
#define PG8_STAGE(bufoff, gbase, voff) do { _Pragma("unroll") for (int _i = 0; _i < 2; ++_i) \
        __builtin_amdgcn_global_load_lds((const unsigned*)((const char*)(gbase) + (voff)[_i]), (PG8_LAS unsigned*)(lds + (bufoff) + ldsw + _i * 8192), 16, 0, 0); } while (0)
#define PG8_LDA(dst, b, h) do { _Pragma("unroll") for (int m = 0; m < 4; ++m) _Pragma("unroll") for (int k = 0; k < 2; ++k) dst[m][k] = *(const PG8_LAS bf16x8*)(lds + PG8_SA(b, h) + aoff + m * 2048 + k * 1024); } while (0)
#define PG8_LDB(dst, b, h) do { _Pragma("unroll") for (int n = 0; n < 2; ++n) _Pragma("unroll") for (int k = 0; k < 2; ++k) dst[n][k] = *(const PG8_LAS bf16x8*)(lds + PG8_SB(b, h) + boff + n * 2048 + k * 1024); } while (0)
#define PG8_MMA(ai, bj, At, Bt) do { __builtin_amdgcn_s_setprio(1); _Pragma("unroll") for (int m = 0; m < 4; ++m) _Pragma("unroll") for (int n = 0; n < 2; ++n) _Pragma("unroll") for (int k = 0; k < 2; ++k) \
        acc[ai][bj][m][n] = __builtin_amdgcn_mfma_f32_16x16x32_bf16(Bt[n][k], At[m][k], acc[ai][bj][m][n], 0, 0, 0); __builtin_amdgcn_s_setprio(0); } while (0)
#define PG8_WAIT_V(n) asm volatile("s_waitcnt vmcnt(" #n ")" ::: "memory")
#define PG8_WAIT_L(n) asm volatile("s_waitcnt lgkmcnt(" #n ")" ::: "memory")
#define PG8_BAR __builtin_amdgcn_s_barrier()
#define PG8_SCHED __builtin_amdgcn_sched_barrier(0)
    Unit cur, nxt; int ui = 0;
    if (!S.next(0, cur)) return;
    f32x4 acc[2][2][4][2];
#pragma unroll
    for (int a = 0; a < 2; ++a)
#pragma unroll
        for (int b = 0; b < 2; ++b)
#pragma unroll
            for (int m = 0; m < 4; ++m)
#pragma unroll
                for (int n = 0; n < 2; ++n) acc[a][b][m][n] = (f32x4){0.f, 0.f, 0.f, 0.f};
    bf16x8 At[4][2], B0[2][2], B1[2][2];
    const char* cA = (const char*)g.A + (size_t)cur.pm * tstep; const char* cB = (const char*)g.Bt + (size_t)cur.pn * tstep;
    S.a_ready(cur);
    if constexpr (SP2) {
        PG8_STAGE(PG8_SB(0, 0), cB, voffB); PG8_STAGE(PG8_SB(0, 1), cB + hstep, voffB); PG8_STAGE(PG8_SA(0, 0), cA, voffA); PG8_STAGE(PG8_SA(0, 1), cA + hstep, voffA);
        if (wr == 1) PG8_BAR;
        PG8_WAIT_V(2); PG8_BAR;
        PG8_STAGE(PG8_SB(1, 0), cB + kstep, voffB); PG8_STAGE(PG8_SA(1, 0), cA + kstep, voffA); PG8_STAGE(PG8_SB(1, 1), cB + hstep + kstep, voffB);
        PG8_WAIT_V(6); PG8_BAR;
    } else {
        PG8_STAGE(PG8_SB(0, 0), cB, voffB); PG8_STAGE(PG8_SA(0, 0), cA, voffA); PG8_STAGE(PG8_SB(0, 1), cB + hstep, voffB); PG8_STAGE(PG8_SA(0, 1), cA + hstep, voffA);
        if (wr == 1) PG8_BAR;
        PG8_WAIT_V(4); PG8_BAR;
        PG8_STAGE(PG8_SB(1, 0), cB + kstep, voffB); PG8_STAGE(PG8_SA(1, 0), cA + kstep, voffA); PG8_STAGE(PG8_SB(1, 1), cB + hstep + kstep, voffB);
        PG8_WAIT_V(6); PG8_BAR;
    }
    for (;;) {
        const bool has_next = S.next(ui + 1, nxt);
        const char* nA = has_next ? (const char*)g.A + (size_t)nxt.pm * tstep : cA; const char* nB = has_next ? (const char*)g.Bt + (size_t)nxt.pn * tstep : cB;
#pragma unroll 1
        for (int t = 0; t < nt; t += 2) {
            const bool last = (t == nt - 2);
            const char* a1 = cA + (size_t)(t + 1) * kstep;
            const char* a2 = last ? nA : cA + (size_t)(t + 2) * kstep; const char* b2 = last ? nB : cB + (size_t)(t + 2) * kstep;
            const char* a3 = a2 + kstep; const char* b3 = b2 + kstep;
            if (last && has_next) S.a_ready(nxt);
            if constexpr (SP2) {
            PG8_LDB(B0, 0, 0); PG8_LDB(B1, 0, 1); PG8_SCHED; PG8_LDA(At, 0, 0); PG8_STAGE(PG8_SA(1, 1), a1 + hstep, voffA);
            PG8_WAIT_V(8); PG8_WAIT_L(0); PG8_BAR; PG8_MMA(0, 0, At, B0); PG8_MMA(0, 1, At, B1); PG8_BAR; PG8_SCHED;
            PG8_LDA(At, 0, 1); PG8_STAGE(PG8_SB(0, 0), b2, voffB); PG8_STAGE(PG8_SB(0, 1), b2 + hstep, voffB); PG8_STAGE(PG8_SA(0, 0), a2, voffA);
            PG8_WAIT_V(8); PG8_WAIT_L(0); PG8_BAR; PG8_MMA(1, 0, At, B0); PG8_MMA(1, 1, At, B1); PG8_BAR; PG8_SCHED;
            PG8_LDB(B0, 1, 0); PG8_LDB(B1, 1, 1); PG8_SCHED; PG8_LDA(At, 1, 0); PG8_STAGE(PG8_SA(0, 1), a2 + hstep, voffA);
            PG8_WAIT_V(8); PG8_WAIT_L(0); PG8_BAR; PG8_MMA(0, 0, At, B0); PG8_MMA(0, 1, At, B1); PG8_BAR; PG8_SCHED;
            PG8_LDA(At, 1, 1); PG8_STAGE(PG8_SB(1, 0), b3, voffB); PG8_STAGE(PG8_SB(1, 1), b3 + hstep, voffB); PG8_STAGE(PG8_SA(1, 0), a3, voffA);
            PG8_WAIT_V(8); PG8_WAIT_L(0); PG8_BAR; PG8_MMA(1, 0, At, B0); PG8_MMA(1, 1, At, B1); PG8_BAR; PG8_SCHED;
            } else {
            PG8_LDB(B0, 0, 0); PG8_SCHED; PG8_LDA(At, 0, 0); PG8_STAGE(PG8_SA(1, 1), a1 + hstep, voffA);
            PG8_WAIT_L(8); PG8_BAR; PG8_WAIT_L(0); PG8_MMA(0, 0, At, B0); PG8_BAR; PG8_SCHED;
            PG8_LDB(B1, 0, 1); PG8_STAGE(PG8_SB(0, 0), b2, voffB);
            PG8_BAR; PG8_WAIT_L(0); PG8_MMA(0, 1, At, B1); PG8_BAR;
            PG8_LDA(At, 0, 1); PG8_STAGE(PG8_SA(0, 0), a2, voffA);
            PG8_BAR; PG8_WAIT_L(0); PG8_MMA(1, 0, At, B0); PG8_BAR; PG8_SCHED;
            PG8_STAGE(PG8_SB(0, 1), b2 + hstep, voffB);
            PG8_WAIT_V(6); PG8_BAR; PG8_MMA(1, 1, At, B1); PG8_BAR;
            PG8_LDB(B0, 1, 0); PG8_SCHED; PG8_LDA(At, 1, 0); PG8_STAGE(PG8_SA(0, 1), a2 + hstep, voffA);
            PG8_WAIT_L(8); PG8_BAR; PG8_WAIT_L(0); PG8_MMA(0, 0, At, B0); PG8_BAR; PG8_SCHED;
            PG8_LDB(B1, 1, 1); PG8_STAGE(PG8_SB(1, 0), b3, voffB);
            PG8_BAR; PG8_WAIT_L(0); PG8_MMA(0, 1, At, B1); PG8_BAR;
            PG8_LDA(At, 1, 1); PG8_STAGE(PG8_SA(1, 0), a3, voffA);
            PG8_BAR; PG8_WAIT_L(0); PG8_MMA(1, 0, At, B0); PG8_BAR; PG8_SCHED;
            PG8_STAGE(PG8_SB(1, 1), b3 + hstep, voffB);
            PG8_WAIT_V(6); PG8_BAR; PG8_MMA(1, 1, At, B1); PG8_BAR;
            }
        }
        if constexpr (ALIGN_EPI) { if (wr == 0) PG8_BAR; }
        if constexpr (!Epi::AFTER_DRAIN) { E(acc, cur, wr, wc, fr, fq); S.done(cur); }
        if (!has_next) break;
#pragma unroll
        for (int a = 0; a < 2; ++a)
#pragma unroll
            for (int b = 0; b < 2; ++b)
#pragma unroll
                for (int m = 0; m < 4; ++m)
#pragma unroll
                    for (int n = 0; n < 2; ++n) acc[a][b][m][n] = (f32x4){0.f, 0.f, 0.f, 0.f};
        cur = nxt; cA = nA; cB = nB; ++ui;
        if constexpr (ALIGN_EPI) { if (wr == 1) PG8_BAR; }
    }
    PG8_WAIT_V(0);
    if constexpr (!ALIGN_EPI) { if (wr == 0) PG8_BAR; }
    PG8_BAR;
    if constexpr (Epi::AFTER_DRAIN) { E.fused(acc, cur, wr, wc, fr, fq, lds, wid, lane); S.done(cur); }
#undef PG8_SA
#undef PG8_SB
#undef PG8_STAGE
#undef PG8_LDA
#undef PG8_LDB
#undef PG8_MMA
#undef PG8_WAIT_V
#undef PG8_WAIT_L
#undef PG8_BAR
#undef PG8_SCHED
}
}

#define GAS __attribute__((address_space(1)))
#define LAS __attribute__((address_space(3)))
typedef unsigned short bf16;
typedef unsigned v4u __attribute__((ext_vector_type(4)));
typedef float f32x4 __attribute__((ext_vector_type(4)));
typedef short bf16x8 __attribute__((ext_vector_type(8)));
typedef GAS unsigned gu32;
typedef GAS unsigned long long gu64;
#define RLX_AGENT __ATOMIC_RELAXED, __HIP_MEMORY_SCOPE_AGENT
#define LDS_WAIT() asm volatile("s_waitcnt lgkmcnt(0)" ::: "memory")
#define VM_WAIT() asm volatile("s_waitcnt vmcnt(0)" ::: "memory")
__device__ __forceinline__ unsigned long long rt() { return __builtin_amdgcn_s_memrealtime(); }
__device__ __forceinline__ unsigned f2bf(float f) { unsigned u = __builtin_bit_cast(unsigned, f); return (u + 0x7fffu + ((u >> 16) & 1u)) >> 16; }
__device__ __forceinline__ unsigned pk2(float lo, float hi) { return f2bf(lo) | (f2bf(hi) << 16); }

#define XB_TMO      128
#define XB_XCNT(j)  (256  + 64 * (j))
#define XB_XSUB(j)  (1280 + 64 * (j))
#define XB_XGEN(j)  (2304 + 64 * (j))
#define XB_TOP      3328
#define XB_TOPGEN   3392
#define XCD_BAR_WORDS 3456
#define XB_SPIN_CAP (1u << 18)

__device__ __forceinline__ unsigned xb_ld(unsigned* p)              { return __hip_atomic_load(p, __ATOMIC_RELAXED, __HIP_MEMORY_SCOPE_AGENT); }
__device__ __forceinline__ unsigned xb_add(unsigned* p, unsigned v) { return __hip_atomic_fetch_add(p, v, __ATOMIC_RELAXED, __HIP_MEMORY_SCOPE_AGENT); }
__device__ __forceinline__ unsigned xb_xcc_id() { return (unsigned)__builtin_amdgcn_s_getreg((3 << 11) | 20) & 0xFu; }
#define XB_SPIN(cond, bar) do { unsigned _sp = 0; while (cond) { __builtin_amdgcn_s_sleep(1); \
    if ((++_sp & 255u) == 0u) { if (xb_ld(&(bar)[XB_TMO])) break; if (_sp > XB_SPIN_CAP) { atomicAdd(&(bar)[XB_TMO], 1u); break; } } } } while (0)

struct XcdBarrier {
    unsigned* bar; unsigned x;
    volatile LAS unsigned* st;
};

__device__ __forceinline__ XcdBarrier xcd_barrier_post(unsigned* bar, volatile LAS unsigned* st) {
    XcdBarrier b; b.bar = bar; b.x = xb_xcc_id(); b.st = st;
    if (threadIdx.x == 0) (void)xb_add(&bar[XB_XCNT(b.x)], 1u);
    return b;
}
__device__ __forceinline__ void xcd_barrier_complete(unsigned* bar, unsigned x, unsigned& nloc, unsigned& nx) {
    const unsigned G = gridDim.x * gridDim.y * gridDim.z;
    unsigned sum, cnt, mine, sp = 0u;
    for (;;) {
        sum = 0u; cnt = 0u; mine = 0u;
#pragma unroll
        for (unsigned j = 0; j < 16; ++j) { const unsigned c = xb_ld(&bar[XB_XCNT(j)]); sum += c; cnt += (c > 0u) ? 1u : 0u; mine = (j == x) ? c : mine; }
        if (sum == G) break;
        __builtin_amdgcn_s_sleep(1);
        if ((++sp & 255u) == 0u) { if (xb_ld(&bar[XB_TMO])) break; if (sp > XB_SPIN_CAP) { atomicAdd(&bar[XB_TMO], 1u); break; } }
    }
    nloc = mine > 0u ? mine : 1u; nx = cnt > 0u ? cnt : 1u;
}

__device__ __forceinline__ void xcd_barrier(const XcdBarrier& b) {
    asm volatile("s_waitcnt vmcnt(0)" ::: "memory");
    __syncthreads();
    if (threadIdx.x == 0) {
        unsigned* bar = b.bar;
        __builtin_amdgcn_s_waitcnt(0);
        unsigned nloc = b.st[0], nx = b.st[1];
        if (nloc == 0u) { xcd_barrier_complete(bar, b.x, nloc, nx); b.st[0] = nloc; b.st[1] = nx; }
        const unsigned old = xb_add(&bar[XB_XSUB(b.x)], 1u);
        const unsigned gen = old / nloc;
        if (old + 1u == (gen + 1u) * nloc) {
            __builtin_amdgcn_fence(__ATOMIC_RELEASE, "agent");
            asm volatile("s_waitcnt vmcnt(0)" ::: "memory");
            const unsigned og = xb_add(&bar[XB_TOP], 1u);
            const unsigned tg = og / nx;
            if (og + 1u == (tg + 1u) * nx) xb_add(&bar[XB_TOPGEN], 1u);
            else XB_SPIN(xb_ld(&bar[XB_TOPGEN]) == tg, bar);
            __builtin_amdgcn_fence(__ATOMIC_ACQUIRE, "agent");
            xb_add(&bar[XB_XGEN(b.x)], 1u);
            asm volatile("s_waitcnt vmcnt(0)" ::: "memory");
        } else {
            XB_SPIN(xb_ld(&bar[XB_XGEN(b.x)]) == gen, bar);
            __builtin_amdgcn_fence(__ATOMIC_ACQUIRE, "agent");
            asm volatile("s_waitcnt vmcnt(0)" ::: "memory");
        }
    }
    __syncthreads();
}

struct Args { const void* in[18]; float* out; unsigned char* ws; int ph_lo, ph_hi; };

#ifndef PG8_SP2
#define PG8_SP2 true
#endif
#ifndef PG8_ALIGN
#define PG8_ALIGN true
#endif
constexpr int NWAVES = 8;
constexpr int BATCH = 8, T = 4096, D = 1024, M = BATCH * T;
constexpr int NIN0 = 648, NIN0P = 768, DFF = 2816, NGU = 2 * DFF, NQQ = 2048, NHIN = 4096;
constexpr float ALPHA = 1.4142135623730951f;
constexpr float LN_EPS = 1e-5f, RMS_EPS = 1e-6f;
constexpr size_t MiB = 1u << 20;
constexpr size_t WS_CTL = 0, CTL_ZERO_BYTES = 1 * MiB;
constexpr size_t WS_W_IN0 = 2 * MiB, WS_W_Q = 4 * MiB, WS_W_O0 = 5 * MiB, WS_W_HIN = 7 * MiB, WS_W_HO = 15 * MiB;
constexpr size_t WS_W_GU0 = 17 * MiB, WS_W_DN0 = 28 * MiB, WS_W_GU1 = 34 * MiB, WS_W_DN1 = 45 * MiB;
constexpr size_t WS_COSQ = 51 * MiB, WS_SINQ = 52 * MiB, WS_COSI = 53 * MiB, WS_SINI = 55 * MiB, WS_LB = 57 * MiB;
constexpr size_t WS_RES = 60 * MiB, WS_HB = 188 * MiB;
constexpr size_t WS_CQ = 252 * MiB, WS_KVB = 268 * MiB, WS_KIDX = 284 * MiB, WS_WIDX = 292 * MiB, WS_SEL = 294 * MiB, WS_H0 = 310 * MiB, WS_QQ = 310 * MiB, WS_O = 438 * MiB;
constexpr size_t WS_SCR = WS_RES, WS_ACT = 252 * MiB, WS_HH = 252 * MiB, WS_END = 508 * MiB;
constexpr int CW_BAR = 4096;
constexpr int RING_OFF = 0, RING_BYTES = 131072;
constexpr int LDSCTL_OFF = RING_BYTES, MISC_OFF = LDSCTL_OFF + 320;
constexpr int LDS_BYTES = 147456;

typedef unsigned short u16;
typedef float f32x2 __attribute__((ext_vector_type(2)));
typedef float f32x16 __attribute__((ext_vector_type(16)));
typedef unsigned u32x2 __attribute__((ext_vector_type(2)));
typedef int i32x4 __attribute__((ext_vector_type(4)));

__device__ __forceinline__ float bf2f(unsigned h) { return __uint_as_float(h << 16); }
__device__ __forceinline__ float wave_sum(float v) {
#pragma unroll
    for (int o = 1; o < 64; o <<= 1) v += __shfl_xor(v, o);
    return v;
}
__device__ __forceinline__ int wave_sum_i(int v) {
#pragma unroll
    for (int o = 1; o < 64; o <<= 1) v += __shfl_xor(v, o);
    return v;
}
__device__ const float INVQ[8] = {1.000000000e+00f, 1.939227432e-01f, 3.760603070e-02f, 7.292664610e-03f, 1.414213562e-03f, 2.742481884e-04f, 5.318296098e-05f, 1.031338616e-05f};
__device__ const float INVI[16] = {1.000000000e+00f, 4.403665960e-01f, 1.939227432e-01f, 8.539710194e-02f, 3.760603070e-02f, 1.656043902e-02f, 7.292664610e-03f, 3.211445874e-03f,
                                   1.414213562e-03f, 6.227723788e-04f, 2.742481884e-04f, 1.207697351e-04f, 5.318296098e-05f, 2.341999971e-05f, 1.031338616e-05f, 4.541670478e-06f};

__device__ __forceinline__ void tr_item(const float* W, int K, int N, bf16* WT, int dst_row0, int k0, int n0, LAS float* scr, int lane) {
    const int n_ld = n0 + (lane & 31);
#pragma unroll 8
    for (int i = 0; i < 32; ++i) { const int kk = 2 * i + (lane >> 5); scr[kk * 33 + (lane & 31)] = (n_ld < N) ? W[(size_t)(k0 + kk) * N + n_ld] : 0.f; }
    LDS_WAIT(); asm volatile("" ::: "memory");
    const int c = lane & 7;
#pragma unroll
    for (int j = 0; j < 4; ++j) { const int n = (lane >> 3) + 8 * j; const LAS float* s = scr + (8 * c) * 33 + n;
        v4u o; o.x = pk2(s[0 * 33], s[1 * 33]); o.y = pk2(s[2 * 33], s[3 * 33]); o.z = pk2(s[4 * 33], s[5 * 33]); o.w = pk2(s[6 * 33], s[7 * 33]);
        *(v4u*)(WT + (size_t)(dst_row0 + n) * K + k0 + 8 * c) = o; }
    LDS_WAIT(); asm volatile("" ::: "memory");
}
__device__ __forceinline__ void tr_matrix_item(const float* W, int K, int N, bf16* WT, int row_off, bool grp, int it, LAS float* scr, int lane) {
    const int nblk = (N + 31) >> 5, kb = it / nblk, nb = it - kb * nblk, n0 = 32 * nb;
    const int dst = (grp ? ((n0 >> 7) * 256 + (n0 & 127)) : n0) + row_off;
    tr_item(W, K, N, WT, dst, 64 * kb, n0, scr, lane);
}
__device__ __forceinline__ void p0_prologue(const Args& A, unsigned char* ws, LAS unsigned char* lds, int gw, int NGW, int wave, int lane, int gtid, int NT) {
    LAS float* scr = (LAS float*)(lds + RING_OFF + wave * 16384);
    const float* w_in = (const float*)A.in[2]; const float* w_uq = (const float*)A.in[4]; const float* w_iq = (const float*)A.in[5]; const float* w_o = (const float*)A.in[8];
    const float* hw_in = (const float*)A.in[10]; const float* hw_o = (const float*)A.in[12];
    const float* wg = (const float*)A.in[13]; const float* wu = (const float*)A.in[14]; const float* wd = (const float*)A.in[15];
    constexpr int I0 = 16 * 21, I1 = 4 * 32, I3 = 16 * 32, I4 = 16 * 128, I6 = 16 * 88, I10 = 44 * 32;
    constexpr int NITEMS = I0 + 2 * I1 + I3 + I4 + I3 + 4 * I6 + 2 * I10;
    for (int it = gw; it < NITEMS; it += NGW) {
        int r = it;
        if (r < I0) { tr_matrix_item(w_in, 1024, NIN0, (bf16*)(ws + WS_W_IN0), 0, false, r, scr, lane); continue; } r -= I0;
        if (r < I1) { tr_matrix_item(w_uq, 256, 1024, (bf16*)(ws + WS_W_Q), 0, false, r, scr, lane); continue; } r -= I1;
        if (r < I1) { tr_matrix_item(w_iq, 256, 1024, (bf16*)(ws + WS_W_Q), 1024, false, r, scr, lane); continue; } r -= I1;
        if (r < I3) { tr_matrix_item(w_o, 1024, 1024, (bf16*)(ws + WS_W_O0), 0, false, r, scr, lane); continue; } r -= I3;
        if (r < I4) { tr_matrix_item(hw_in, 1024, 4096, (bf16*)(ws + WS_W_HIN), 0, false, r, scr, lane); continue; } r -= I4;
        if (r < I3) { tr_matrix_item(hw_o, 1024, 1024, (bf16*)(ws + WS_W_HO), 0, false, r, scr, lane); continue; } r -= I3;
        if (r < I6) { tr_matrix_item(wg, 1024, DFF, (bf16*)(ws + WS_W_GU0), 0, true, r, scr, lane); continue; } r -= I6;
        if (r < I6) { tr_matrix_item(wu, 1024, DFF, (bf16*)(ws + WS_W_GU0), 128, true, r, scr, lane); continue; } r -= I6;
        if (r < I6) { tr_matrix_item(wg + (size_t)1024 * DFF, 1024, DFF, (bf16*)(ws + WS_W_GU1), 0, true, r, scr, lane); continue; } r -= I6;
        if (r < I6) { tr_matrix_item(wu + (size_t)1024 * DFF, 1024, DFF, (bf16*)(ws + WS_W_GU1), 128, true, r, scr, lane); continue; } r -= I6;
        if (r < I10) { tr_matrix_item(wd, DFF, 1024, (bf16*)(ws + WS_W_DN0), 0, false, r, scr, lane); continue; } r -= I10;
        tr_matrix_item(wd + (size_t)DFF * 1024, DFF, 1024, (bf16*)(ws + WS_W_DN1), 0, false, r, scr, lane);
    }
    { v4u* z = (v4u*)(ws + WS_W_IN0 + (size_t)672 * 1024 * 2); const int nz = 96 * 1024 * 2 / 16;
      for (int i = gtid; i < nz; i += NT) z[i] = (v4u){0u, 0u, 0u, 0u}; }
    { const f32x4* x4 = (const f32x4*)A.in[0]; v4u* xb = (v4u*)(ws + WS_HB); const int n8 = M * D / 8;
      for (int i = gtid; i < n8; i += NT) { const f32x4 a = x4[2 * i], b = x4[2 * i + 1];
          v4u o; o.x = pk2(a.x, a.y); o.y = pk2(a.z, a.w); o.z = pk2(b.x, b.y); o.w = pk2(b.z, b.w); xb[i] = o; } }
    { const int* pos = (const int*)A.in[1]; float* cq = (float*)(ws + WS_COSQ); float* sq = (float*)(ws + WS_SINQ); float* ci = (float*)(ws + WS_COSI); float* si = (float*)(ws + WS_SINI);
      for (int idx = gtid; idx < M * 24; idx += NT) { const int m = idx / 24, i = idx - m * 24;
          const float inv = (i < 8) ? INVQ[i] : INVI[i - 8];
          const float ang = (float)pos[m] * inv;
          const double rev = (double)ang * 0.15915494309189535; const float fr = (float)(rev - floor(rev));
          const float c = __builtin_amdgcn_cosf(fr), s = __builtin_amdgcn_sinf(fr);
          if (i < 8) { cq[m * 8 + i] = c; sq[m * 8 + i] = s; } else { ci[m * 16 + i - 8] = c; si[m * 16 + i - 8] = s; } } }
    { const float* lbl = (const float*)A.in[9]; float* lb = (float*)(ws + WS_LB);
      for (int c = gtid; c < 1024; c += NT) lb[c] = 1.0f / (1.0f + expf(lbl[c] - lbl[1024 + c])); }
}

__device__ __forceinline__ void p2_fixup(const Args& A, unsigned char* ws, int gw, int NGW, int lane) {
    const float* H0 = (const float*)(ws + WS_H0); bf16* CQ = (bf16*)(ws + WS_CQ); bf16* KVB = (bf16*)(ws + WS_KVB); bf16* KIDX = (bf16*)(ws + WS_KIDX); float* WIDX = (float*)(ws + WS_WIDX);
    const float* cosq = (const float*)(ws + WS_COSQ); const float* sinq = (const float*)(ws + WS_SINQ); const float* cosi = (const float*)(ws + WS_COSI); const float* sini = (const float*)(ws + WS_SINI);
    const float* g_cq = (const float*)A.in[3]; const float* g_ik = (const float*)A.in[6]; const float* b_ik = (const float*)A.in[7];
    const f32x4 gc = *(const f32x4*)(g_cq + 4 * lane);
    const f32x2 gi = *(const f32x2*)(g_ik + 2 * lane), bi = *(const f32x2*)(b_ik + 2 * lane);
    for (int m = gw; m < M; m += NGW) {
        const float* h = H0 + (size_t)m * NIN0P;
        const f32x4 cqv = *(const f32x4*)(h + 4 * lane);
        f32x4 kv = *(const f32x4*)(h + 256 + 4 * lane);
        const f32x2 ki = *(const f32x2*)(h + 512 + 2 * lane);
        const float wv = (lane < 8) ? h[640 + lane] : 0.f;
        { const float ss = wave_sum((cqv.x * cqv.x + cqv.y * cqv.y) + (cqv.z * cqv.z + cqv.w * cqv.w));
          const float rs = 1.0f / sqrtf(ss * (1.0f / 256.0f) + RMS_EPS);
          u32x2 o; o.x = pk2(cqv.x * rs * gc.x, cqv.y * rs * gc.y); o.y = pk2(cqv.z * rs * gc.z, cqv.w * rs * gc.w);
          *(u32x2*)(CQ + (size_t)m * 256 + 4 * lane) = o; }
        { f32x4 ot; ot.x = __shfl_xor(kv.x, 2); ot.y = __shfl_xor(kv.y, 2); ot.z = __shfl_xor(kv.z, 2); ot.w = __shfl_xor(kv.w, 2);
          const int sub = lane & 15;
          if (lane < 32 && sub < 4) { const int i0 = 4 * (sub & 1);
              const f32x4 c = *(const f32x4*)(cosq + (size_t)m * 8 + i0), s = *(const f32x4*)(sinq + (size_t)m * 8 + i0);
              if (sub < 2) kv = kv * c - ot * s; else kv = kv * c + ot * s; }
          u32x2 o; o.x = pk2(kv.x, kv.y); o.y = pk2(kv.z, kv.w);
          *(u32x2*)(KVB + (size_t)m * 256 + 4 * lane) = o; }
        { const float mu = wave_sum(ki.x + ki.y) * (1.0f / 128.0f); const float dx = ki.x - mu, dy = ki.y - mu;
          const float var = wave_sum(dx * dx + dy * dy) * (1.0f / 128.0f); const float rstd = 1.0f / sqrtf(var + LN_EPS);
          float x = dx * rstd * gi.x + bi.x, y = dy * rstd * gi.y + bi.y;
          const float ox = __shfl_xor(x, 8), oy = __shfl_xor(y, 8);
          if (lane < 16) { const int i0 = 2 * (lane & 7);
              const f32x2 c = *(const f32x2*)(cosi + (size_t)m * 16 + i0), s = *(const f32x2*)(sini + (size_t)m * 16 + i0);
              if (lane < 8) { x = x * c.x - ox * s.x; y = y * c.y - oy * s.y; } else { x = x * c.x + ox * s.x; y = y * c.y + oy * s.y; } }
          *(unsigned*)(KIDX + (size_t)m * 128 + 2 * lane) = pk2(x, y); }
        if (lane < 8) WIDX[(size_t)m * 8 + lane] = wv * 0.03125f;
    }
}
__device__ __forceinline__ void p4_rope(unsigned char* ws, int gw, int NGW, int lane) {
    bf16* QQ = (bf16*)(ws + WS_QQ);
    const float* cosq = (const float*)(ws + WS_COSQ); const float* sinq = (const float*)(ws + WS_SINQ); const float* cosi = (const float*)(ws + WS_COSI); const float* sini = (const float*)(ws + WS_SINI);
    for (int m = gw; m < M; m += NGW) {
        bf16* q = QQ + (size_t)m * NQQ;
#pragma unroll
        for (int pp = 0; pp < 2; ++pp) { const int p = lane + 64 * pp, hh = p >> 3, i = p & 7, c1 = hh * 64 + i, c2 = c1 + 8;
            const float x1 = bf2f(q[c1]), x2 = bf2f(q[c2]), c = cosq[(size_t)m * 8 + i], s = sinq[(size_t)m * 8 + i];
            q[c1] = (bf16)f2bf(x1 * c - x2 * s); q[c2] = (bf16)f2bf(x2 * c + x1 * s); }
#pragma unroll
        for (int pp = 0; pp < 2; ++pp) { const int p = lane + 64 * pp, hh = p >> 4, i = p & 15, c1 = 1024 + hh * 128 + i, c2 = c1 + 16;
            const float x1 = bf2f(q[c1]), x2 = bf2f(q[c2]), c = cosi[(size_t)m * 16 + i], s = sini[(size_t)m * 16 + i];
            q[c1] = (bf16)f2bf(x1 * c - x2 * s); q[c2] = (bf16)f2bf(x2 * c + x1 * s); }
    }
}
__device__ __forceinline__ void ln_rows(const float* res, float* outf, bf16* hb, const float* g, const float* bt, int gw, int NGW, int lane) {
    f32x4 gv[4], bv[4];
#pragma unroll
    for (int j = 0; j < 4; ++j) { gv[j] = *(const f32x4*)(g + 4 * lane + 256 * j); bv[j] = *(const f32x4*)(bt + 4 * lane + 256 * j); }
    for (int m = gw; m < M; m += NGW) {
        const f32x4* xr = (const f32x4*)(res + (size_t)m * D) + lane;
        f32x4 v[4]; float s = 0.f;
#pragma unroll
        for (int j = 0; j < 4; ++j) { v[j] = xr[64 * j]; s += (v[j].x + v[j].y) + (v[j].z + v[j].w); }
        const float mean = wave_sum(s) * (1.f / D); float s2 = 0.f;
#pragma unroll
        for (int j = 0; j < 4; ++j) { v[j] = v[j] - mean; s2 += (v[j].x * v[j].x + v[j].y * v[j].y) + (v[j].z * v[j].z + v[j].w * v[j].w); }
        const float rstd = 1.f / sqrtf(wave_sum(s2) * (1.f / D) + LN_EPS);
        f32x4* orow = (f32x4*)(outf + (size_t)m * D) + lane;
#pragma unroll
        for (int j = 0; j < 4; ++j) { const f32x4 y = v[j] * rstd * gv[j] + bv[j]; orow[64 * j] = y;
            if (hb) { u32x2 o; o.x = pk2(y.x, y.y); o.y = pk2(y.z, y.w); *(u32x2*)(hb + (size_t)m * D + 4 * lane + 256 * j) = o; } }
    }
}
__device__ __forceinline__ void p15_gate(const Args& A, unsigned char* ws, int gw, int NGW, int lane) {
    bf16* OR = (bf16*)(ws + WS_HB); const bf16* HH = (const bf16*)(ws + WS_HH); const float* gn = (const float*)A.in[11];
    float gnv[16];
#pragma unroll
    for (int j = 0; j < 16; ++j) gnv[j] = gn[((16 * lane) & 127) + j];
    for (int m = gw; m < M; m += NGW) {
        const v4u o0 = *(const v4u*)(OR + (size_t)m * D + 16 * lane), o1 = *(const v4u*)(OR + (size_t)m * D + 16 * lane + 8);
        const v4u g0 = *(const v4u*)(HH + (size_t)m * NHIN + 3072 + 16 * lane), g1 = *(const v4u*)(HH + (size_t)m * NHIN + 3072 + 16 * lane + 8);
        float o[16], gg[16];
#pragma unroll
        for (int j = 0; j < 4; ++j) { o[2 * j] = bf2f(o0[j] & 0xffffu); o[2 * j + 1] = bf2f(o0[j] >> 16); o[8 + 2 * j] = bf2f(o1[j] & 0xffffu); o[8 + 2 * j + 1] = bf2f(o1[j] >> 16);
            gg[2 * j] = bf2f(g0[j] & 0xffffu); gg[2 * j + 1] = bf2f(g0[j] >> 16); gg[8 + 2 * j] = bf2f(g1[j] & 0xffffu); gg[8 + 2 * j + 1] = bf2f(g1[j] >> 16); }
        float ss = 0.f;
#pragma unroll
        for (int j = 0; j < 16; ++j) ss += o[j] * o[j];
        ss += __shfl_xor(ss, 1); ss += __shfl_xor(ss, 2); ss += __shfl_xor(ss, 4);
        const float rs = 1.0f / sqrtf(ss * (1.0f / 128.0f) + RMS_EPS);
        v4u w0, w1;
#pragma unroll
        for (int j = 0; j < 4; ++j) { w0[j] = pk2(o[2 * j] * rs * gnv[2 * j] * gg[2 * j], o[2 * j + 1] * rs * gnv[2 * j + 1] * gg[2 * j + 1]);
            w1[j] = pk2(o[8 + 2 * j] * rs * gnv[8 + 2 * j] * gg[8 + 2 * j], o[8 + 2 * j + 1] * rs * gnv[8 + 2 * j + 1] * gg[8 + 2 * j + 1]); }
        *(v4u*)(OR + (size_t)m * D + 16 * lane) = w0; *(v4u*)(OR + (size_t)m * D + 16 * lane + 8) = w1;
    }
}

#define MFMA32(a, b, c) __builtin_amdgcn_mfma_f32_32x32x16_bf16((a), (b), (c), 0, 0, 0)
#define MFMA16(a, b, c) __builtin_amdgcn_mfma_f32_16x16x32_bf16((a), (b), (c), 0, 0, 0)
#define BLOCK_SYNC() do { asm volatile("s_waitcnt vmcnt(0) lgkmcnt(0)" ::: "memory"); __builtin_amdgcn_s_barrier(); asm volatile("" ::: "memory"); } while (0)
#define LDS_SYNC() do { asm volatile("s_waitcnt lgkmcnt(0)" ::: "memory"); __builtin_amdgcn_s_barrier(); asm volatile("" ::: "memory"); } while (0)

#ifndef TOPK_ON
#define TOPK_ON 1
#endif
constexpr int IDX_ROWB = 272, IDX_BUF = 64 * IDX_ROWB;
__device__ __forceinline__ unsigned ord_key(float f) { const unsigned u = __float_as_uint(f); return (u & 0x80000000u) ? ~u : (u | 0x80000000u); }

__device__ __forceinline__ void topk_token(const float* srow, int t, u16* selrow, int lane) {
    const int n = t + 1;
    if (n <= 256) {
        u32x2 o; const int j = 4 * lane;
        o.x = (unsigned)((j <= t) ? j : 0) | ((unsigned)((j + 1 <= t) ? j + 1 : 0) << 16);
        o.y = (unsigned)((j + 2 <= t) ? j + 2 : 0) | ((unsigned)((j + 3 <= t) ? j + 3 : 0) << 16);
        *(u32x2*)(selrow + j) = o;
        return;
    }
    const int nch = (n + 255) >> 8;
    unsigned u[16][4];
#pragma unroll
    for (int i = 0; i < 16; ++i) {
        if (i < nch) { const f32x4 v = __builtin_nontemporal_load((const f32x4*)(srow + 256 * i + 4 * lane));
#pragma unroll
            for (int e = 0; e < 4; ++e) { const int s = 256 * i + 4 * lane + e; float f = v[e]; f = (f == 0.f) ? 0.f : f; u[i][e] = (s <= t) ? ord_key(f) : 0u; } }
        else {
#pragma unroll
            for (int e = 0; e < 4; ++e) u[i][e] = 0u; }
    }
    unsigned prefix = 0u;
#pragma unroll 1
    for (int bit = 31; bit >= 0; --bit) {
        const unsigned cand = prefix | (1u << bit); int c = 0;
#pragma unroll
        for (int i = 0; i < 16; ++i) if (i < nch) {
#pragma unroll
            for (int e = 0; e < 4; ++e) c += (u[i][e] >= cand) ? 1 : 0; }
        c = wave_sum_i(c);
        if (c >= 256) prefix = cand;
    }
    unsigned mlo = 0u, mhi = 0u; int ceq = 0;
    int sb4 = 4096 - 4 * lane; asm volatile("" : "+v"(sb4));
#pragma unroll
    for (int i = 15; i >= 0; --i)
#pragma unroll
        for (int e = 3; e >= 0; --e) { const int bit = 4 * i + e; const unsigned key = u[i][e]; const unsigned gt = (key > prefix) ? 1u : 0u; const bool eq = (key == prefix);
            if (bit < 32) mlo = (mlo << 1) | gt; else mhi = (mhi << 1) | gt;
            ceq += eq ? 1 : 0; u[i][e] = eq ? (unsigned)(sb4 - (256 * i + e)) : 0u; }
    const int cgt = wave_sum_i(__builtin_popcount(mlo) + __builtin_popcount(mhi)); ceq = wave_sum_i(ceq);
    const int need = 256 - cgt;
    unsigned p2 = 1u;
    if (ceq > need) {
        p2 = 0u;
#pragma unroll 1
        for (int bit = 12; bit >= 0; --bit) { const unsigned cand = p2 | (1u << bit); int c = 0;
#pragma unroll
            for (int i = 0; i < 16; ++i)
#pragma unroll
                for (int e = 0; e < 4; ++e) c += (u[i][e] >= cand) ? 1 : 0;
            c = wave_sum_i(c);
            if (c >= need) p2 = cand; }
    }
    unsigned elo = 0u, ehi = 0u;
#pragma unroll
    for (int i = 15; i >= 0; --i)
#pragma unroll
        for (int e = 3; e >= 0; --e) { const int bit = 4 * i + e; const unsigned sl = (u[i][e] >= p2) ? 1u : 0u; if (bit < 32) elo = (elo << 1) | sl; else ehi = (ehi << 1) | sl; }
    mlo |= elo; mhi |= ehi;
    const int cnt = __builtin_popcount(mlo) + __builtin_popcount(mhi);
    int incl = cnt;
#pragma unroll
    for (int o = 1; o < 64; o <<= 1) { const int v = __shfl_up(incl, o); if (lane >= o) incl += v; }
    int pos = incl - cnt;
    u16* wp = selrow + pos;
    while (mlo) { const int bit = __builtin_ctz(mlo); mlo &= mlo - 1u; *wp++ = (u16)(256 * (bit >> 2) + 4 * lane + (bit & 3)); }
    while (mhi) { const int bit = __builtin_ctz(mhi) + 32; mhi &= mhi - 1u; *wp++ = (u16)(256 * (bit >> 2) + 4 * lane + (bit & 3)); }
}

__device__ __forceinline__ void idx_tile(int b, int qt, const bf16* QQ, const bf16* KIDX, const float* WIDX, float* scr, u16* SEL, LAS unsigned char* lds, int tid, int wave, int lane) {
    const int t0 = 32 * qt, m0 = b * T + t0, nkt = (t0 + 32 + 63) >> 6;
    const int r = lane & 31, hi = lane >> 5;
    const int tokl = 2 * (r >> 4) + ((r >> 2) & 1), hh = 4 * ((r >> 3) & 1) + (r & 3);
    const bf16* qrow = QQ + (size_t)(m0 + 4 * wave + tokl) * NQQ + 1024 + hh * 128 + 8 * hi;
    bf16x8 qa[8];
#pragma unroll
    for (int ks = 0; ks < 8; ++ks) qa[ks] = *(const bf16x8*)(qrow + 16 * ks);
    const f32x4 wa0 = *(const f32x4*)(WIDX + (size_t)(m0 + 4 * wave + hi) * 8), wa1 = *(const f32x4*)(WIDX + (size_t)(m0 + 4 * wave + hi) * 8 + 4);
    const f32x4 wb0 = *(const f32x4*)(WIDX + (size_t)(m0 + 4 * wave + 2 + hi) * 8), wb1 = *(const f32x4*)(WIDX + (size_t)(m0 + 4 * wave + 2 + hi) * 8 + 4);
    const v4u* kg = (const v4u*)(KIDX + (size_t)(b * T) * 128);
    const int c0 = tid, c1 = tid + 512;
    const int l0 = (c0 >> 4) * IDX_ROWB + (c0 & 15) * 16, l1 = (c1 >> 4) * IDX_ROWB + (c1 & 15) * 16;
    v4u p0 = kg[c0], p1 = kg[c1];
    *(LAS v4u*)(lds + l0) = p0; *(LAS v4u*)(lds + l1) = p1;
    LDS_SYNC();
    float* s0p = scr + (size_t)(4 * wave + hi) * 4096 + r;
    float* s1p = scr + (size_t)(4 * wave + 2 + hi) * 4096 + r;
    for (int kt = 0; kt < nkt; ++kt) {
        const int buf = kt & 1;
        if (kt + 1 < nkt) { p0 = kg[(kt + 1) * 1024 + c0]; p1 = kg[(kt + 1) * 1024 + c1]; }
        const LAS unsigned char* kb = lds + buf * IDX_BUF + r * IDX_ROWB + 16 * hi;
#pragma unroll
        for (int blk = 0; blk < 2; ++blk) {
            f32x16 acc = {0.f, 0.f, 0.f, 0.f, 0.f, 0.f, 0.f, 0.f, 0.f, 0.f, 0.f, 0.f, 0.f, 0.f, 0.f, 0.f};
#pragma unroll
            for (int ks = 0; ks < 8; ++ks) { const bf16x8 kf = *(const LAS bf16x8*)(kb + blk * 32 * IDX_ROWB + 32 * ks); acc = MFMA32(qa[ks], kf, acc); }
            float sA = 0.f, sB = 0.f;
#pragma unroll
            for (int i = 0; i < 4; ++i) { sA += wa0[i] * fmaxf(acc[i], 0.f) + wa1[i] * fmaxf(acc[4 + i], 0.f); sB += wb0[i] * fmaxf(acc[8 + i], 0.f) + wb1[i] * fmaxf(acc[12 + i], 0.f); }
            s0p[kt * 64 + blk * 32] = sA; s1p[kt * 64 + blk * 32] = sB;
        }
        if (kt + 1 < nkt) { *(LAS v4u*)(lds + (buf ^ 1) * IDX_BUF + l0) = p0; *(LAS v4u*)(lds + (buf ^ 1) * IDX_BUF + l1) = p1; }
        LDS_SYNC();
    }
    BLOCK_SYNC();
#pragma unroll 1
    for (int j = 0; j < 4; ++j) { const int tl = 4 * wave + j; if (TOPK_ON) topk_token(scr + (size_t)tl * 4096, t0 + tl, SEL + (size_t)(m0 + tl) * 256, lane); }
    BLOCK_SYNC();
}
__device__ __forceinline__ void p5_index(unsigned char* ws, LAS unsigned char* lds, int tid, int wave, int lane, int vcu, int G) {
    const bf16* QQ = (const bf16*)(ws + WS_QQ); const bf16* KIDX = (const bf16*)(ws + WS_KIDX); const float* WIDX = (const float*)(ws + WS_WIDX);
    float* scr = (float*)(ws + WS_SCR) + (size_t)vcu * (32 * 4096); u16* SEL = (u16*)(ws + WS_SEL);
    for (int p = vcu; p < BATCH * 64; p += G) { const int b = p >> 6, q = p & 63;
        idx_tile(b, q, QQ, KIDX, WIDX, scr, SEL, lds, tid, wave, lane);
        idx_tile(b, 127 - q, QQ, KIDX, WIDX, scr, SEL, lds, tid, wave, lane); }
}

__device__ __forceinline__ void attn_token(int m, const bf16* QQ, const bf16* KVB, const u16* SEL, bf16* O, LAS unsigned char* wl, int lane) {
    const int t = m & (T - 1), b = m >> 12; const int n = (t + 1 < 256) ? t + 1 : 256;
    LAS int* sel_l = (LAS int*)wl; LAS float* ps = (LAS float*)(wl + 1024);
    { const u32x2 sv = *(const u32x2*)(SEL + (size_t)m * 256 + 4 * lane); const int j = 4 * lane;
      i32x4 o; o.x = (j < n) ? (int)(sv.x & 0xffffu) : 0; o.y = (j + 1 < n) ? (int)(sv.x >> 16) : 0; o.z = (j + 2 < n) ? (int)(sv.y & 0xffffu) : 0; o.w = (j + 3 < n) ? (int)(sv.y >> 16) : 0;
      *(LAS i32x4*)(sel_l + j) = o; }
    LDS_WAIT(); asm volatile("" ::: "memory");
    const int fr = lane & 15, fq = lane >> 4;
    const bf16* kvb = KVB + (size_t)(b * T) * 256;
#pragma unroll 1
    for (int g = 0; g < 2; ++g) {
        bf16x8 qf0 = {0, 0, 0, 0, 0, 0, 0, 0}, qf1 = {0, 0, 0, 0, 0, 0, 0, 0};
        if (fr < 8) { const bf16* qp = QQ + (size_t)m * NQQ + (8 * g + fr) * 64 + 8 * fq; qf0 = *(const bf16x8*)qp; qf1 = *(const bf16x8*)(qp + 32); }
        f32x4 sa[16];
#pragma unroll
        for (int tile = 0; tile < 16; ++tile) { const int s = sel_l[tile * 16 + fr];
            const bf16* kr = kvb + (size_t)s * 256 + g * 64 + 8 * fq;
            const bf16x8 k0 = *(const bf16x8*)kr, k1 = *(const bf16x8*)(kr + 32);
            f32x4 a = {0.f, 0.f, 0.f, 0.f}; a = MFMA16(k0, qf0, a); a = MFMA16(k1, qf1, a); sa[tile] = a; }
        float mx = -INFINITY;
#pragma unroll
        for (int tile = 0; tile < 16; ++tile)
#pragma unroll
            for (int e = 0; e < 4; ++e) { const int j = tile * 16 + 4 * fq + e; const float v = (j < n) ? sa[tile][e] * 0.125f : -INFINITY; sa[tile][e] = v; mx = fmaxf(mx, v); }
        mx = fmaxf(mx, __shfl_xor(mx, 16)); mx = fmaxf(mx, __shfl_xor(mx, 32));
        float sum = 0.f;
#pragma unroll
        for (int tile = 0; tile < 16; ++tile)
#pragma unroll
            for (int e = 0; e < 4; ++e) { const float p = __expf(sa[tile][e] - mx); sa[tile][e] = p; sum += p; }
        sum += __shfl_xor(sum, 16); sum += __shfl_xor(sum, 32);
        const float inv = 1.0f / sum;
        if (fr < 8) {
#pragma unroll
            for (int tile = 0; tile < 16; ++tile) *(LAS f32x4*)(ps + fr * 256 + tile * 16 + 4 * fq) = sa[tile] * inv; }
        LDS_WAIT(); asm volatile("" ::: "memory");
        float o[8] = {0.f, 0.f, 0.f, 0.f, 0.f, 0.f, 0.f, 0.f};
        const bf16* vb = kvb + 128 + g * 64 + lane;
        const int n4 = (n + 3) >> 2;
#pragma unroll 2
        for (int j4 = 0; j4 < n4; ++j4) {
            const i32x4 s4 = *(const LAS i32x4*)(sel_l + 4 * j4);
            const float v0 = bf2f(vb[(size_t)__builtin_amdgcn_readfirstlane(s4.x) * 256]), v1 = bf2f(vb[(size_t)__builtin_amdgcn_readfirstlane(s4.y) * 256]);
            const float v2 = bf2f(vb[(size_t)__builtin_amdgcn_readfirstlane(s4.z) * 256]), v3 = bf2f(vb[(size_t)__builtin_amdgcn_readfirstlane(s4.w) * 256]);
#pragma unroll
            for (int h = 0; h < 8; ++h) { const f32x4 p4 = *(const LAS f32x4*)(ps + h * 256 + 4 * j4); o[h] += (p4.x * v0 + p4.y * v1) + (p4.z * v2 + p4.w * v3); }
        }
#pragma unroll
        for (int h = 0; h < 8; ++h) O[(size_t)m * D + (8 * g + h) * 64 + lane] = (bf16)f2bf(o[h]);
        LDS_WAIT(); asm volatile("" ::: "memory");
    }
}

constexpr int HG_QT = 0, HG_KT = 17408, HG_QH = 34816, HG_KHT = 52224, HG_VT = 70656, HG_AL = 75264, HG_ST = 84480, HG_DV = 101888, HG_TOT = 102400;
__device__ __forceinline__ void hgrn_item(int item, const bf16* HH, bf16* ORAW, LAS unsigned char* lds, int tid, int wave, int lane) {
    const int b = item >> 5, h = (item >> 2) & 7, vs = item & 3;
    const int kp = lane, rq = wave;
    const bf16* qp = HH + (size_t)(b * T) * NHIN + h * 128 + 2 * kp;
    const int vrow = tid >> 3, v4 = (tid & 7) * 4;
    const bf16* vp = HH + (size_t)(b * T) * NHIN + 2048 + h * 128 + vs * 32 + v4;
    for (int i = tid; i < 2 * 8704 / 4; i += 512) ((LAS unsigned*)(lds + HG_ST))[i] = 0u;
    f32x16 accS = {0.f, 0.f, 0.f, 0.f, 0.f, 0.f, 0.f, 0.f, 0.f, 0.f, 0.f, 0.f, 0.f, 0.f, 0.f, 0.f};
    const int r = lane & 31, hi = lane >> 5;
    unsigned qw[8], fw[8]; u32x2 vw;
#pragma unroll
    for (int i = 0; i < 8; ++i) { const bf16* p = qp + (size_t)(8 * rq + i) * NHIN; qw[i] = *(const unsigned*)p; fw[i] = *(const unsigned*)(p + 1024); }
    vw = *(const u32x2*)(vp + (size_t)vrow * NHIN);
    LDS_SYNC();
#pragma unroll 1
    for (int c = 0; c < 64; ++c) {
        unsigned qc[8], fc[8]; const u32x2 vc = vw;
#pragma unroll
        for (int i = 0; i < 8; ++i) { qc[i] = qw[i]; fc[i] = fw[i]; }
        if (c + 1 < 64) {
#pragma unroll
            for (int i = 0; i < 8; ++i) { const bf16* p = qp + (size_t)(64 * (c + 1) + 8 * rq + i) * NHIN; qw[i] = *(const unsigned*)p; fw[i] = *(const unsigned*)(p + 1024); }
            vw = *(const u32x2*)(vp + (size_t)(64 * (c + 1) + vrow) * NHIN);
        }
        float b0[8], b1[8]; float r0 = 0.f, r1 = 0.f;
#pragma unroll
        for (int i = 0; i < 8; ++i) { r0 += bf2f(fc[i] & 0xffffu); r1 += bf2f(fc[i] >> 16); b0[i] = r0; b1[i] = r1; }
        *(LAS f32x2*)(lds + HG_TOT + (rq * 128 + 2 * kp) * 4) = (f32x2){r0, r1};
        { LAS u16* vt = (LAS u16*)(lds + HG_VT);
          vt[(v4 + 0) * 72 + vrow] = (u16)(vc.x & 0xffffu); vt[(v4 + 1) * 72 + vrow] = (u16)(vc.x >> 16); vt[(v4 + 2) * 72 + vrow] = (u16)(vc.y & 0xffffu); vt[(v4 + 3) * 72 + vrow] = (u16)(vc.y >> 16); }
        LDS_SYNC();
        float pre0 = 0.f, pre1 = 0.f, ref0 = 0.f, ref1 = 0.f, last0 = 0.f, last1 = 0.f;
#pragma unroll
        for (int q = 0; q < 8; ++q) { const f32x2 tt = *(const LAS f32x2*)(lds + HG_TOT + (q * 128 + 2 * kp) * 4);
            if (q < rq) { pre0 += tt.x; pre1 += tt.y; } if (q < 4) { ref0 += tt.x; ref1 += tt.y; } last0 += tt.x; last1 += tt.y; }
        unsigned kh0[4], kh1[4];
#pragma unroll
        for (int i = 0; i < 8; ++i) { const int row = 8 * rq + i;
            const float bb0 = pre0 + b0[i], bb1 = pre1 + b1[i];
            const float q0 = bf2f(qc[i] & 0xffffu), q1 = bf2f(qc[i] >> 16);
            const float k0 = 1.0f - __expf(bf2f(fc[i] & 0xffffu)), k1 = 1.0f - __expf(bf2f(fc[i] >> 16));
            const float qt0 = q0 * __expf(bb0 - ref0), qt1 = q1 * __expf(bb1 - ref1);
            const float kt0 = k0 * __expf(ref0 - bb0), kt1 = k1 * __expf(ref1 - bb1);
            const float qh0 = q0 * __expf(bb0), qh1 = q1 * __expf(bb1);
            const float kk0 = k0 * __expf(last0 - bb0), kk1 = k1 * __expf(last1 - bb1);
            *(LAS unsigned*)(lds + HG_QT + row * 272 + 4 * kp) = pk2(qt0, qt1);
            *(LAS unsigned*)(lds + HG_KT + row * 272 + 4 * kp) = pk2(kt0, kt1);
            *(LAS unsigned*)(lds + HG_QH + row * 272 + 4 * kp) = pk2(qh0, qh1);
            if (i & 1) { kh0[i >> 1] |= f2bf(kk0) << 16; kh1[i >> 1] |= f2bf(kk1) << 16; } else { kh0[i >> 1] = f2bf(kk0); kh1[i >> 1] = f2bf(kk1); } }
        *(LAS v4u*)(lds + HG_KHT + (2 * kp) * 144 + 16 * rq) = (v4u){kh0[0], kh0[1], kh0[2], kh0[3]};
        *(LAS v4u*)(lds + HG_KHT + (2 * kp + 1) * 144 + 16 * rq) = (v4u){kh1[0], kh1[1], kh1[2], kh1[3]};
        if (rq == 0) *(LAS f32x2*)(lds + HG_DV + 8 * kp) = (f32x2){__expf(last0), __expf(last1)};
        LDS_SYNC();
        if (wave < 3) {
            const int sb = (wave == 2) ? 1 : 0, tb = (wave == 0) ? 0 : 1;
            f32x16 a = {0.f, 0.f, 0.f, 0.f, 0.f, 0.f, 0.f, 0.f, 0.f, 0.f, 0.f, 0.f, 0.f, 0.f, 0.f, 0.f};
#pragma unroll
            for (int ks = 0; ks < 8; ++ks) { const bf16x8 ka = *(const LAS bf16x8*)(lds + HG_KT + (32 * sb + r) * 272 + 32 * ks + 16 * hi);
                const bf16x8 qb = *(const LAS bf16x8*)(lds + HG_QT + (32 * tb + r) * 272 + 32 * ks + 16 * hi); a = MFMA32(ka, qb, a); }
#pragma unroll
            for (int g4 = 0; g4 < 4; ++g4) { float v[4];
#pragma unroll
                for (int e = 0; e < 4; ++e) { const int sl = 8 * g4 + 4 * hi + e; v[e] = (sb != tb || sl <= r) ? a[4 * g4 + e] : 0.f; }
                *(LAS u32x2*)(lds + HG_AL + (32 * tb + r) * 144 + (32 * sb + 8 * g4 + 4 * hi) * 2) = (u32x2){pk2(v[0], v[1]), pk2(v[2], v[3])}; }
        } else if (wave >= 4) {
            const int kb = wave - 4;
#pragma unroll
            for (int i = 0; i < 16; ++i) accS[i] *= *(const LAS float*)(lds + HG_DV + (32 * kb + (i & 3) + 8 * (i >> 2) + 4 * hi) * 4);
#pragma unroll
            for (int ks = 0; ks < 4; ++ks) { const bf16x8 ka = *(const LAS bf16x8*)(lds + HG_KHT + (32 * kb + r) * 144 + 32 * ks + 16 * hi);
                const bf16x8 vb = *(const LAS bf16x8*)(lds + HG_VT + r * 144 + 32 * ks + 16 * hi); accS = MFMA32(ka, vb, accS); }
            LAS unsigned char* st = lds + HG_ST + ((c + 1) & 1) * 8704;
#pragma unroll
            for (int g4 = 0; g4 < 4; ++g4) *(LAS u32x2*)(st + r * 272 + (32 * kb + 8 * g4 + 4 * hi) * 2) = (u32x2){pk2(accS[4 * g4], accS[4 * g4 + 1]), pk2(accS[4 * g4 + 2], accS[4 * g4 + 3])};
        }
        LDS_SYNC();
        if (wave < 2) {
            const int tb = wave;
            f32x16 o = {0.f, 0.f, 0.f, 0.f, 0.f, 0.f, 0.f, 0.f, 0.f, 0.f, 0.f, 0.f, 0.f, 0.f, 0.f, 0.f};
#pragma unroll
            for (int ks = 0; ks < 4; ++ks) if (ks < 2 || tb == 1) { const bf16x8 aa = *(const LAS bf16x8*)(lds + HG_AL + (32 * tb + r) * 144 + 32 * ks + 16 * hi);
                const bf16x8 vb = *(const LAS bf16x8*)(lds + HG_VT + r * 144 + 32 * ks + 16 * hi); o = MFMA32(aa, vb, o); }
            const LAS unsigned char* st = lds + HG_ST + (c & 1) * 8704;
#pragma unroll
            for (int ks = 0; ks < 8; ++ks) { const bf16x8 aa = *(const LAS bf16x8*)(lds + HG_QH + (32 * tb + r) * 272 + 32 * ks + 16 * hi);
                const bf16x8 sb = *(const LAS bf16x8*)(st + r * 272 + 32 * ks + 16 * hi); o = MFMA32(aa, sb, o); }
            bf16* op = ORAW + (size_t)(b * T + 64 * c + 32 * tb) * D + h * 128 + vs * 32 + r;
#pragma unroll
            for (int i = 0; i < 16; ++i) op[(size_t)((i & 3) + 8 * (i >> 2) + 4 * hi) * D] = (bf16)f2bf(o[i]);
        }
        LDS_SYNC();
    }
}

__global__ void __launch_bounds__(NWAVES * 64, 2) mk_fwd(Args args) {
    extern __shared__ __attribute__((aligned(16))) unsigned char lds_raw[];
    LAS unsigned char* lds = (LAS unsigned char*)lds_raw;
    volatile LAS unsigned* MISC = (volatile LAS unsigned*)(lds + MISC_OFF);
    const int tid = threadIdx.x, lane = tid & 63, wave = __builtin_amdgcn_readfirstlane(tid >> 6);
    const int G = gridDim.x; const int bx = blockIdx.x; const int vcu = (G % 8 == 0) ? (bx % 8) * (G / 8) + bx / 8 : bx;
    const int gw = vcu * NWAVES + wave, NGW = G * NWAVES, gtid = vcu * (NWAVES * 64) + tid, NT = G * NWAVES * 64;
    unsigned char* ws = args.ws;
    gu32* ctl = (gu32*)(ws + WS_CTL);
    for (int u = tid; u < (LDS_BYTES - LDSCTL_OFF) / 4; u += NWAVES * 64) ((LAS unsigned*)(lds + LDSCTL_OFF))[u] = 0u;
    __syncthreads();
    XcdBarrier bar = xcd_barrier_post((unsigned*)(ctl + CW_BAR), MISC + 8);
    const int lo = args.ph_lo, hi = args.ph_hi;
#ifndef PHMASK
#define PHMASK 0xFFFFFu
#endif
#define IN(k) ((((PHMASK) >> (k)) & 1u) && lo <= (k) && (k) < hi)
#define SEAM(k) do { if (IN(k) && IN((k) + 1)) xcd_barrier(bar); } while (0)
    const float* x_in = (const float*)args.in[0];
    const float* ln_g = (const float*)args.in[16]; const float* ln_b = (const float*)args.in[17];
    float* RES = (float*)(ws + WS_RES); bf16* HB = (bf16*)(ws + WS_HB);

    if (IN(0)) p0_prologue(args, ws, lds, gw, NGW, wave, lane, gtid, NT);
    SEAM(0);
    if (IN(1)) {
        pg8::Gemm g{(const bf16*)(ws + WS_HB), (const bf16*)(ws + WS_W_IN0), M, NIN0P, D}; pg8::StaticOrder S; S.init(M, NIN0P, G, bx);
        pg8::EpiF32 E{(float*)(ws + WS_H0), NIN0P};
        pg8::gemm_phase<pg8::EpiF32, pg8::StaticOrder, PG8_ALIGN, PG8_SP2>(lds + RING_OFF, g, S, E);
    }
    SEAM(1);
    if (IN(2)) p2_fixup(args, ws, gw, NGW, lane);
    SEAM(2);
    if (IN(3)) {
        pg8::Gemm g{(const bf16*)(ws + WS_CQ), (const bf16*)(ws + WS_W_Q), M, NQQ, 256}; pg8::StaticOrder S; S.init(M, NQQ, G, bx);
        pg8::EpiBf16 E{(bf16*)(ws + WS_QQ), NQQ};
        pg8::gemm_phase<pg8::EpiBf16, pg8::StaticOrder, PG8_ALIGN, PG8_SP2>(lds + RING_OFF, g, S, E);
    }
    SEAM(3);
    if (IN(4)) p4_rope(ws, gw, NGW, lane);
    SEAM(4);
    if (IN(5)) p5_index(ws, lds, tid, wave, lane, vcu, G);
    SEAM(5);
    if (IN(6)) {
        const bf16* QQ = (const bf16*)(ws + WS_QQ); const bf16* KVB = (const bf16*)(ws + WS_KVB); const u16* SEL = (const u16*)(ws + WS_SEL); bf16* O = (bf16*)(ws + WS_O);
        for (int m = gw; m < M; m += NGW) attn_token(m, QQ, KVB, SEL, O, lds + RING_OFF + wave * 16384, lane);
    }
    SEAM(6);
    if (IN(7)) {
        pg8::Gemm g{(const bf16*)(ws + WS_O), (const bf16*)(ws + WS_W_O0), M, D, D}; pg8::StaticOrder S; S.init(M, D, G, bx);
        pg8::EpiRes E{x_in, RES, D, ALPHA};
        pg8::gemm_phase<pg8::EpiRes, pg8::StaticOrder, PG8_ALIGN, PG8_SP2>(lds + RING_OFF, g, S, E);
    }
    SEAM(7);
    if (IN(8)) ln_rows(RES, RES, HB, ln_g, ln_b, gw, NGW, lane);
    SEAM(8);
    if (IN(9)) {
        pg8::Gemm g{HB, (const bf16*)(ws + WS_W_GU0), M, NGU, D}; pg8::StaticOrder S; S.init(M, NGU, G, bx);
        pg8::EpiSwiGLU E{(bf16*)(ws + WS_ACT), DFF};
        pg8::gemm_phase<pg8::EpiSwiGLU, pg8::StaticOrder, PG8_ALIGN, PG8_SP2>(lds + RING_OFF, g, S, E);
    }
    SEAM(9);
    if (IN(10)) {
        pg8::Gemm g{(const bf16*)(ws + WS_ACT), (const bf16*)(ws + WS_W_DN0), M, D, DFF}; pg8::StaticOrder S; S.init(M, D, G, bx);
        pg8::EpiRes E{RES, RES, D, ALPHA};
        pg8::gemm_phase<pg8::EpiRes, pg8::StaticOrder, PG8_ALIGN, PG8_SP2>(lds + RING_OFF, g, S, E);
    }
    SEAM(10);
    if (IN(11)) ln_rows(RES, RES, HB, ln_g + D, ln_b + D, gw, NGW, lane);
    SEAM(11);
    if (IN(12)) {
        pg8::Gemm g{HB, (const bf16*)(ws + WS_W_HIN), M, NHIN, D}; pg8::StaticOrder S; S.init(M, NHIN, G, bx);
        pg8::EpiHgrnIn E{(bf16*)(ws + WS_HH), NHIN, (const float*)(ws + WS_LB)};
        pg8::gemm_phase<pg8::EpiHgrnIn, pg8::StaticOrder, PG8_ALIGN, PG8_SP2>(lds + RING_OFF, g, S, E);
    }
    SEAM(12);
    if (IN(13)) { for (int item = vcu; item < 256; item += G) hgrn_item(item, (const bf16*)(ws + WS_HH), HB, lds + RING_OFF, tid, wave, lane); }
    SEAM(13);
    if (IN(14)) p15_gate(args, ws, gw, NGW, lane);
    SEAM(14);
    if (IN(15)) {
        pg8::Gemm g{HB, (const bf16*)(ws + WS_W_HO), M, D, D}; pg8::StaticOrder S; S.init(M, D, G, bx);
        pg8::EpiRes E{RES, RES, D, ALPHA};
        pg8::gemm_phase<pg8::EpiRes, pg8::StaticOrder, PG8_ALIGN, PG8_SP2>(lds + RING_OFF, g, S, E);
    }
    SEAM(15);
    if (IN(16)) ln_rows(RES, RES, HB, ln_g + 2 * D, ln_b + 2 * D, gw, NGW, lane);
    SEAM(16);
    if (IN(17)) {
        pg8::Gemm g{HB, (const bf16*)(ws + WS_W_GU1), M, NGU, D}; pg8::StaticOrder S; S.init(M, NGU, G, bx);
        pg8::EpiSwiGLU E{(bf16*)(ws + WS_ACT), DFF};
        pg8::gemm_phase<pg8::EpiSwiGLU, pg8::StaticOrder, PG8_ALIGN, PG8_SP2>(lds + RING_OFF, g, S, E);
    }
    SEAM(17);
    if (IN(18)) {
        pg8::Gemm g{(const bf16*)(ws + WS_ACT), (const bf16*)(ws + WS_W_DN1), M, D, DFF}; pg8::StaticOrder S; S.init(M, D, G, bx);
        pg8::EpiRes E{RES, RES, D, ALPHA};
        pg8::gemm_phase<pg8::EpiRes, pg8::StaticOrder, PG8_ALIGN, PG8_SP2>(lds + RING_OFF, g, S, E);
    }
    SEAM(18);
    if (IN(19)) ln_rows(RES, args.out, nullptr, ln_g + 3 * D, ln_b + 3 * D, gw, NGW, lane);
#undef IN
#undef SEAM
}

extern "C" void kernel_launch(void* const* d_in, const int* in_sizes, int n_in, void* d_out, int out_size, void* d_ws, size_t ws_size, hipStream_t stream) {
    static int grid = 0;
    if (grid == 0) {
        if (n_in != 18 || in_sizes[0] != M * D || out_size != M * D || ws_size < WS_END) { fprintf(stderr, "kernel_launch: unexpected shapes (n_in %d, in0 %d, out %d, ws %zu)\n", n_in, n_in > 0 ? in_sizes[0] : -1, out_size, ws_size); grid = -1; return; }
        int dev = 0, cus = 0;
        if (hipGetDevice(&dev) != hipSuccess || hipDeviceGetAttribute(&cus, hipDeviceAttributeMultiprocessorCount, dev) != hipSuccess) { grid = -1; return; }
        if (hipFuncSetAttribute((const void*)mk_fwd, hipFuncAttributeMaxDynamicSharedMemorySize, LDS_BYTES) != hipSuccess) { fprintf(stderr, "kernel_launch: hipFuncSetAttribute failed\n"); grid = -1; return; }
        int per_cu = 0;
        if (hipOccupancyMaxActiveBlocksPerMultiprocessor(&per_cu, (const void*)mk_fwd, NWAVES * 64, LDS_BYTES) != hipSuccess || per_cu < 1) fprintf(stderr, "kernel_launch: occupancy query says %d\n", per_cu);
        (void)hipGetLastError();
        grid = cus;
    }
    if (grid < 0) return;
    if (hipMemsetAsync((char*)d_ws + WS_CTL, 0, CTL_ZERO_BYTES, stream) != hipSuccess) return;
    Args a{};
    for (int i = 0; i < 18; ++i) a.in[i] = d_in[i];
    a.out = (float*)d_out; a.ws = (unsigned char*)d_ws;
#ifndef MK_CUTS
    a.ph_lo = 0; a.ph_hi = 20;
    hipLaunchKernelGGL(mk_fwd, dim3(grid), dim3(NWAVES * 64), LDS_BYTES, stream, a);
#else
    for (int p = 0; p < 20; ++p) { a.ph_lo = p; a.ph_hi = p + 1; hipLaunchKernelGGL(mk_fwd, dim3(grid), dim3(NWAVES * 64), LDS_BYTES, stream, a); }
#endif
}
```

```cpp
#include <hip/hip_runtime.h>
#include <cstdio>
#include <cstdint>
namespace pg8 {
#define PG8_LAS __attribute__((address_space(3)))
typedef unsigned short bf16_t;
typedef short bf16x8 __attribute__((ext_vector_type(8)));
typedef float f32x4 __attribute__((ext_vector_type(4)));
typedef unsigned u32x4 __attribute__((ext_vector_type(4)));
constexpr int BM = 256, BK = 64, HALF = 128, HTB = HALF * BK * 2  , STAGE_BYTES = 8 * HTB, NXCD = 8, WGM = 8;

__host__ __device__ __forceinline__ int lds_byte(int r, int c) { const int st = (r >> 4) * 2 + (c >> 5), rr = r & 15, cc = c & 31, ob = rr * 64 + cc * 2; return st * 1024 + (ob ^ (((ob >> 9) & 1) << 5)); }
__host__ __device__ __forceinline__ void stage_rc(int b, int& R, int& C) { const int st = b / 1024, sb = b % 1024, swz = sb ^ (((sb >> 9) & 1) << 5); R = (st >> 1) * 16 + swz / 64; C = (st & 1) * 32 + (swz % 64) / 2; }
__host__ __device__ __forceinline__ int perm32(int rho) { const int n = rho >> 4, i = rho & 15; return 8 * (i >> 2) + 4 * n + (i & 3); }

struct Unit { int pm, pn; };
struct Gemm { const bf16_t* A; const bf16_t* Bt; int M, N, K; };

struct StaticOrder {
    int nM, nN, nwg, G, c;
    __host__ __device__ void init(int M, int N, int G_, int c_) { nM = M / BM; nN = N / BM; nwg = nM * nN; G = G_; c = c_; }
    __host__ __device__ bool next(int i, Unit& u) const {
        const long L = (long)i * G + c; if (L >= nwg) return false;
        int wgid = (int)L; { const int q = nwg / NXCD, r = nwg % NXCD, xcd = wgid % NXCD, off = wgid / NXCD; wgid = (xcd < r ? xcd * (q + 1) : r * (q + 1) + (xcd - r) * q) + off; }
        const int nig = WGM * nN, gid = wgid / nig, fm = gid * WGM, gsz = (nM - fm) < WGM ? (nM - fm) : WGM;
        u.pm = fm + ((wgid % nig) % gsz); u.pn = (wgid % nig) / gsz; return true;
    }
    __device__ __forceinline__ void a_ready(const Unit&) const {}
    __device__ __forceinline__ void done(const Unit&) const {}
};


__device__ __forceinline__ unsigned cvt_pk_bf16(float lo, float hi) { unsigned r; asm volatile("v_cvt_pk_bf16_f32 %0, %1, %2" : "=v"(r) : "v"(lo), "v"(hi)); return r; }
__device__ __forceinline__ float silu_f(float x) { return x * __builtin_amdgcn_rcpf(1.0f + __expf(-x)); }

struct EpiF32 {
    static constexpr bool PERM = false, AFTER_DRAIN = false;
    float* C; int ldc;
    __device__ __forceinline__ void operator()(const f32x4 (&acc)[2][2][4][2], const Unit& u, int wr, int wc, int fr, int fq) const {
        const int row0 = u.pm * BM + wr * 64 + fr, col0 = u.pn * BM + wc * 32 + 4 * fq;
#pragma unroll
        for (int ai = 0; ai < 2; ++ai)
#pragma unroll
            for (int m = 0; m < 4; ++m) { float* rowp = C + (size_t)(row0 + ai * HALF + m * 16) * ldc + col0;
#pragma unroll
                for (int bj = 0; bj < 2; ++bj)
#pragma unroll
                    for (int n = 0; n < 2; ++n) *(f32x4*)(rowp + bj * HALF + n * 16) = acc[ai][bj][m][n]; }
    }
};
struct EpiBf16 {
    static constexpr bool PERM = true, AFTER_DRAIN = false;
    bf16_t* O; int ldc;
    __device__ __forceinline__ void operator()(const f32x4 (&acc)[2][2][4][2], const Unit& u, int wr, int wc, int fr, int fq) const {
        const int row0 = u.pm * BM + wr * 64 + fr, col0 = u.pn * BM + wc * 32 + 8 * fq;
#pragma unroll
        for (int ai = 0; ai < 2; ++ai)
#pragma unroll
            for (int m = 0; m < 4; ++m) { bf16_t* rowp = O + (size_t)(row0 + ai * HALF + m * 16) * ldc + col0;
#pragma unroll
                for (int bj = 0; bj < 2; ++bj) { const f32x4 v0 = acc[ai][bj][m][0], v1 = acc[ai][bj][m][1];
                    u32x4 w; w.x = cvt_pk_bf16(v0[0], v0[1]); w.y = cvt_pk_bf16(v0[2], v0[3]); w.z = cvt_pk_bf16(v1[0], v1[1]); w.w = cvt_pk_bf16(v1[2], v1[3]);
                    *(u32x4*)(rowp + bj * HALF) = w; } }
    }
};
struct EpiRes {
    static constexpr bool PERM = false, AFTER_DRAIN = false;
    const float* base; float* out; int ldc; float alpha;
    __device__ __forceinline__ void operator()(const f32x4 (&acc)[2][2][4][2], const Unit& u, int wr, int wc, int fr, int fq) const {
        const int row0 = u.pm * BM + wr * 64 + fr, col0 = u.pn * BM + wc * 32 + 4 * fq;
#pragma unroll
        for (int ai = 0; ai < 2; ++ai)
#pragma unroll
            for (int m = 0; m < 4; ++m) { const size_t off = (size_t)(row0 + ai * HALF + m * 16) * ldc + col0;
#pragma unroll
                for (int bj = 0; bj < 2; ++bj)
#pragma unroll
                    for (int n = 0; n < 2; ++n) { const f32x4 bs = *(const f32x4*)(base + off + bj * HALF + n * 16); *(f32x4*)(out + off + bj * HALF + n * 16) = bs * alpha + acc[ai][bj][m][n]; }
                if (m & 1) asm volatile("" ::: "memory"); }
    }
};
struct EpiSwiGLU {
    static constexpr bool PERM = true, AFTER_DRAIN = false;
    bf16_t* O; int ldc;
    __device__ __forceinline__ void operator()(const f32x4 (&acc)[2][2][4][2], const Unit& u, int wr, int wc, int fr, int fq) const {
        const int row0 = u.pm * BM + wr * 64 + fr, col0 = u.pn * HALF + wc * 32 + 8 * fq;
#pragma unroll
        for (int ai = 0; ai < 2; ++ai)
#pragma unroll
            for (int m = 0; m < 4; ++m) { bf16_t* rowp = O + (size_t)(row0 + ai * HALF + m * 16) * ldc + col0;
                const f32x4 g0 = acc[ai][0][m][0], g1 = acc[ai][0][m][1], u0 = acc[ai][1][m][0], u1 = acc[ai][1][m][1];
                float r[8];
#pragma unroll
                for (int j = 0; j < 4; ++j) { r[j] = silu_f(g0[j]) * u0[j]; r[4 + j] = silu_f(g1[j]) * u1[j]; }
                u32x4 w; w.x = cvt_pk_bf16(r[0], r[1]); w.y = cvt_pk_bf16(r[2], r[3]); w.z = cvt_pk_bf16(r[4], r[5]); w.w = cvt_pk_bf16(r[6], r[7]);
                *(u32x4*)rowp = w; }
    }
};
struct EpiHgrnIn {
    static constexpr bool PERM = true, AFTER_DRAIN = false;
    bf16_t* O; int ldc; const float* lb;
    __device__ __forceinline__ void operator()(const f32x4 (&acc)[2][2][4][2], const Unit& u, int wr, int wc, int fr, int fq) const {
        const int row0 = u.pm * BM + wr * 64 + fr, col0 = u.pn * BM + wc * 32 + 8 * fq;
        const int type = u.pn >> 2;
        f32x4 lbv[2][2];
#pragma unroll
        for (int bj = 0; bj < 2; ++bj)
#pragma unroll
            for (int n = 0; n < 2; ++n) lbv[bj][n] = *(const f32x4*)(lb + ((col0 + bj * HALF + 4 * n) & 1023));
#pragma unroll
        for (int ai = 0; ai < 2; ++ai)
#pragma unroll
            for (int m = 0; m < 4; ++m) { bf16_t* rowp = O + (size_t)(row0 + ai * HALF + m * 16) * ldc + col0;
#pragma unroll
                for (int bj = 0; bj < 2; ++bj) { f32x4 v[2] = {acc[ai][bj][m][0], acc[ai][bj][m][1]};
#pragma unroll
                    for (int n = 0; n < 2; ++n)
#pragma unroll
                        for (int j = 0; j < 4; ++j) { const float x = v[n][j]; float y = x;
                            if (type == 0 || type == 3) y = silu_f(x);
                            else if (type == 1) { const float l = lbv[bj][n][j]; const float sg = __builtin_amdgcn_rcpf(1.0f + __expf(-x)); y = __logf(l + (1.0f - l) * sg); }
                            v[n][j] = y; }
                    u32x4 w; w.x = cvt_pk_bf16(v[0][0], v[0][1]); w.y = cvt_pk_bf16(v[0][2], v[0][3]); w.z = cvt_pk_bf16(v[1][0], v[1][1]); w.w = cvt_pk_bf16(v[1][2], v[1][3]);
                    *(u32x4*)(rowp + bj * HALF) = w; } }
    }
};


template <class Epi, class Sched, bool ALIGN_EPI = false, bool SP2 = false>
__device__ __forceinline__ void gemm_phase(PG8_LAS unsigned char* lds, const Gemm g, const Sched& S, const Epi& E) {
    const int tid = threadIdx.x, wid = __builtin_amdgcn_readfirstlane(tid >> 6), lane = tid & 63, wr = wid >> 2, wc = wid & 3, fr = lane & 15, fq = lane >> 4;
    const int K = g.K, nt = K / BK;
    unsigned voffA[2], voffB[2];
#pragma unroll
    for (int i = 0; i < 2; ++i) { int R, C; stage_rc(tid * 16 + i * 8192, R, C); const int Rb = Epi::PERM ? ((R & ~31) + perm32(R & 31)) : R;
        voffA[i] = (unsigned)(R * K + C) * 2u; voffB[i] = (unsigned)(Rb * K + C) * 2u; }
    const size_t kstep = (size_t)(BK * 2);
    const size_t hstep = (size_t)HALF * K * 2;
    const size_t tstep = 2 * hstep;
    const unsigned ldsw = (unsigned)wid * 1024u;
    const int aoff = lds_byte(wr * 64 + fr, fq * 8), boff = lds_byte(wc * 32 + fr, fq * 8);
#define PG8_SA(b, h) (((b) * 2 + (h)) * HTB)
#define PG8_SB(b, h) ((4 + (b) * 2 + (h)) * HTB)
#define PG8_STAGE(bufoff, gbase, voff) do { _Pragma("unroll") for (int _i = 0; _i < 2; ++_i) \
        __builtin_amdgcn_global_load_lds((const unsigned*)((const char*)(gbase) + (voff)[_i]), (PG8_LAS unsigned*)(lds + (bufoff) + ldsw + _i * 8192), 16, 0, 0); } while (0)
#define PG8_LDA(dst, b, h) do { _Pragma("unroll") for (int m = 0; m < 4; ++m) _Pragma("unroll") for (int k = 0; k < 2; ++k) dst[m][k] = *(const PG8_LAS bf16x8*)(lds + PG8_SA(b, h) + aoff + m * 2048 + k * 1024); } while (0)
#define PG8_LDB(dst, b, h) do { _Pragma("unroll") for (int n = 0; n < 2; ++n) _Pragma("unroll") for (int k = 0; k < 2; ++k) dst[n][k] = *(const PG8_LAS bf16x8*)(lds + PG8_SB(b, h) + boff + n * 2048 + k * 1024); } while (0)
#define PG8_MMA(ai, bj, At, Bt) do { __builtin_amdgcn_s_setprio(1); _Pragma("unroll") for (int m = 0; m < 4; ++m) _Pragma("unroll") for (int n = 0; n < 2; ++n) _Pragma("unroll") for (int k = 0; k < 2; ++k) \
        acc[ai][bj][m][n] = __builtin_amdgcn_mfma_f32_16x16x32_bf16(Bt[n][k], At[m][k], acc[ai][bj][m][n], 0, 0, 0); __builtin_amdgcn_s_setprio(0); } while (0)
#define PG8_WAIT_V(n) asm volatile("s_waitcnt vmcnt(" #n ")" ::: "memory")
#define PG8_WAIT_L(n) asm volatile("s_waitcnt lgkmcnt(" #n ")" ::: "memory")
#define PG8_BAR __builtin_amdgcn_s_barrier()
#define PG8_SCHED __builtin_amdgcn_sched_barrier(0)
    Unit cur, nxt; int ui = 0;
    if (!S.next(0, cur)) return;
    f32x4 acc[2][2][4][2];
#pragma unroll
    for (int a = 0; a < 2; ++a)
#pragma unroll
        for (int b = 0; b < 2; ++b)
#pragma unroll
            for (int m = 0; m < 4; ++m)
#pragma unroll
                for (int n = 0; n < 2; ++n) acc[a][b][m][n] = (f32x4){0.f, 0.f, 0.f, 0.f};
    bf16x8 At[4][2], B0[2][2], B1[2][2];
    const char* cA = (const char*)g.A + (size_t)cur.pm * tstep; const char* cB = (const char*)g.Bt + (size_t)cur.pn * tstep;
    S.a_ready(cur);
    if constexpr (SP2) {
        PG8_STAGE(PG8_SB(0, 0), cB, voffB); PG8_STAGE(PG8_SB(0, 1), cB + hstep, voffB); PG8_STAGE(PG8_SA(0, 0), cA, voffA); PG8_STAGE(PG8_SA(0, 1), cA + hstep, voffA);
        if (wr == 1) PG8_BAR;
        PG8_WAIT_V(2); PG8_BAR;
        PG8_STAGE(PG8_SB(1, 0), cB + kstep, voffB); PG8_STAGE(PG8_SA(1, 0), cA + kstep, voffA); PG8_STAGE(PG8_SB(1, 1), cB + hstep + kstep, voffB);
        PG8_WAIT_V(6); PG8_BAR;
    } else {
        PG8_STAGE(PG8_SB(0, 0), cB, voffB); PG8_STAGE(PG8_SA(0, 0), cA, voffA); PG8_STAGE(PG8_SB(0, 1), cB + hstep, voffB); PG8_STAGE(PG8_SA(0, 1), cA + hstep, voffA);
        if (wr == 1) PG8_BAR;
        PG8_WAIT_V(4); PG8_BAR;
        PG8_STAGE(PG8_SB(1, 0), cB + kstep, voffB); PG8_STAGE(PG8_SA(1, 0), cA + kstep, voffA); PG8_STAGE(PG8_SB(1, 1), cB + hstep + kstep, voffB);
        PG8_WAIT_V(6); PG8_BAR;
    }
    for (;;) {
        const bool has_next = S.next(ui + 1, nxt);
        const char* nA = has_next ? (const char*)g.A + (size_t)nxt.pm * tstep : cA; const char* nB = has_next ? (const char*)g.Bt + (size_t)nxt.pn * tstep : cB;
#pragma unroll 1
        for (int t = 0; t < nt; t += 2) {
            const bool last = (t == nt - 2);
            const char* a1 = cA + (size_t)(t + 1) * kstep;
            const char* a2 = last ? nA : cA + (size_t)(t + 2) * kstep; const char* b2 = last ? nB : cB + (size_t)(t + 2) * kstep;
            const char* a3 = a2 + kstep; const char* b3 = b2 + kstep;
            if (last && has_next) S.a_ready(nxt);
            if constexpr (SP2) {
            PG8_LDB(B0, 0, 0); PG8_LDB(B1, 0, 1); PG8_SCHED; PG8_LDA(At, 0, 0); PG8_STAGE(PG8_SA(1, 1), a1 + hstep, voffA);
            PG8_WAIT_V(8); PG8_WAIT_L(0); PG8_BAR; PG8_MMA(0, 0, At, B0); PG8_MMA(0, 1, At, B1); PG8_BAR; PG8_SCHED;
            PG8_LDA(At, 0, 1); PG8_STAGE(PG8_SB(0, 0), b2, voffB); PG8_STAGE(PG8_SB(0, 1), b2 + hstep, voffB); PG8_STAGE(PG8_SA(0, 0), a2, voffA);
            PG8_WAIT_V(8); PG8_WAIT_L(0); PG8_BAR; PG8_MMA(1, 0, At, B0); PG8_MMA(1, 1, At, B1); PG8_BAR; PG8_SCHED;
            PG8_LDB(B0, 1, 0); PG8_LDB(B1, 1, 1); PG8_SCHED; PG8_LDA(At, 1, 0); PG8_STAGE(PG8_SA(0, 1), a2 + hstep, voffA);
            PG8_WAIT_V(8); PG8_WAIT_L(0); PG8_BAR; PG8_MMA(0, 0, At, B0); PG8_MMA(0, 1, At, B1); PG8_BAR; PG8_SCHED;
            PG8_LDA(At, 1, 1); PG8_STAGE(PG8_SB(1, 0), b3, voffB); PG8_STAGE(PG8_SB(1, 1), b3 + hstep, voffB); PG8_STAGE(PG8_SA(1, 0), a3, voffA);
            PG8_WAIT_V(8); PG8_WAIT_L(0); PG8_BAR; PG8_MMA(1, 0, At, B0); PG8_MMA(1, 1, At, B1); PG8_BAR; PG8_SCHED;
            } else {
            PG8_LDB(B0, 0, 0); PG8_SCHED; PG8_LDA(At, 0, 0); PG8_STAGE(PG8_SA(1, 1), a1 + hstep, voffA);
            PG8_WAIT_L(8); PG8_BAR; PG8_WAIT_L(0); PG8_MMA(0, 0, At, B0); PG8_BAR; PG8_SCHED;
            PG8_LDB(B1, 0, 1); PG8_STAGE(PG8_SB(0, 0), b2, voffB);
            PG8_BAR; PG8_WAIT_L(0); PG8_MMA(0, 1, At, B1); PG8_BAR;
            PG8_LDA(At, 0, 1); PG8_STAGE(PG8_SA(0, 0), a2, voffA);
            PG8_BAR; PG8_WAIT_L(0); PG8_MMA(1, 0, At, B0); PG8_BAR; PG8_SCHED;
            PG8_STAGE(PG8_SB(0, 1), b2 + hstep, voffB);
            PG8_WAIT_V(6); PG8_BAR; PG8_MMA(1, 1, At, B1); PG8_BAR;
            PG8_LDB(B0, 1, 0); PG8_SCHED; PG8_LDA(At, 1, 0); PG8_STAGE(PG8_SA(0, 1), a2 + hstep, voffA);
            PG8_WAIT_L(8); PG8_BAR; PG8_WAIT_L(0); PG8_MMA(0, 0, At, B0); PG8_BAR; PG8_SCHED;
            PG8_LDB(B1, 1, 1); PG8_STAGE(PG8_SB(1, 0), b3, voffB);
            PG8_BAR; PG8_WAIT_L(0); PG8_MMA(0, 1, At, B1); PG8_BAR;
            PG8_LDA(At, 1, 1); PG8_STAGE(PG8_SA(1, 0), a3, voffA);
            PG8_BAR; PG8_WAIT_L(0); PG8_MMA(1, 0, At, B0); PG8_BAR; PG8_SCHED;
            PG8_STAGE(PG8_SB(1, 1), b3 + hstep, voffB);
            PG8_WAIT_V(6); PG8_BAR; PG8_MMA(1, 1, At, B1); PG8_BAR;
            }
        }
        if constexpr (ALIGN_EPI) { if (wr == 0) PG8_BAR; }
        if constexpr (!Epi::AFTER_DRAIN) { E(acc, cur, wr, wc, fr, fq); S.done(cur); }
        if (!has_next) break;
#pragma unroll
        for (int a = 0; a < 2; ++a)
#pragma unroll
            for (int b = 0; b < 2; ++b)
#pragma unroll
                for (int m = 0; m < 4; ++m)
#pragma unroll
                    for (int n = 0; n < 2; ++n) acc[a][b][m][n] = (f32x4){0.f, 0.f, 0.f, 0.f};
        cur = nxt; cA = nA; cB = nB; ++ui;
        if constexpr (ALIGN_EPI) { if (wr == 1) PG8_BAR; }
    }
    PG8_WAIT_V(0);
    if constexpr (!ALIGN_EPI) { if (wr == 0) PG8_BAR; }
    PG8_BAR;
    if constexpr (Epi::AFTER_DRAIN) { E.fused(acc, cur, wr, wc, fr, fq, lds, wid, lane); S.done(cur); }
#undef PG8_SA
#undef PG8_SB
#undef PG8_STAGE
#undef PG8_LDA
#undef PG8_LDB
#undef PG8_MMA
#undef PG8_WAIT_V
#undef PG8_WAIT_L
#undef PG8_BAR
#undef PG8_SCHED
}
}

#define GAS __attribute__((address_space(1)))
#define LAS __attribute__((address_space(3)))
typedef unsigned short bf16;
typedef unsigned v4u __attribute__((ext_vector_type(4)));
typedef float f32x4 __attribute__((ext_vector_type(4)));
typedef short bf16x8 __attribute__((ext_vector_type(8)));
typedef GAS unsigned gu32;
typedef GAS unsigned long long gu64;
#define RLX_AGENT __ATOMIC_RELAXED, __HIP_MEMORY_SCOPE_AGENT
#define LDS_WAIT() asm volatile("s_waitcnt lgkmcnt(0)" ::: "memory")
#define VM_WAIT() asm volatile("s_waitcnt vmcnt(0)" ::: "memory")
__device__ __forceinline__ unsigned long long rt() { return __builtin_amdgcn_s_memrealtime(); }
__device__ __forceinline__ unsigned f2bf(float f) { unsigned u = __builtin_bit_cast(unsigned, f); return (u + 0x7fffu + ((u >> 16) & 1u)) >> 16; }
__device__ __forceinline__ unsigned pk2(float lo, float hi) { return f2bf(lo) | (f2bf(hi) << 16); }

#define XB_TMO      128
#define XB_XCNT(j)  (256  + 64 * (j))
#define XB_XSUB(j)  (1280 + 64 * (j))
#define XB_XGEN(j)  (2304 + 64 * (j))
#define XB_TOP      3328
#define XB_TOPGEN   3392
#define XCD_BAR_WORDS 3456
#define XB_SPIN_CAP (1u << 18)

__device__ __forceinline__ unsigned xb_ld(unsigned* p)              { return __hip_atomic_load(p, __ATOMIC_RELAXED, __HIP_MEMORY_SCOPE_AGENT); }
__device__ __forceinline__ unsigned xb_add(unsigned* p, unsigned v) { return __hip_atomic_fetch_add(p, v, __ATOMIC_RELAXED, __HIP_MEMORY_SCOPE_AGENT); }
__device__ __forceinline__ unsigned xb_xcc_id() { return (unsigned)__builtin_amdgcn_s_getreg((3 << 11) | 20) & 0xFu; }
#define XB_SPIN(cond, bar) do { unsigned _sp = 0; while (cond) { __builtin_amdgcn_s_sleep(1); \
    if ((++_sp & 255u) == 0u) { if (xb_ld(&(bar)[XB_TMO])) break; if (_sp > XB_SPIN_CAP) { atomicAdd(&(bar)[XB_TMO], 1u); break; } } } } while (0)

struct XcdBarrier {
    unsigned* bar; unsigned x;
    volatile LAS unsigned* st;
};

__device__ __forceinline__ XcdBarrier xcd_barrier_post(unsigned* bar, volatile LAS unsigned* st) {
    XcdBarrier b; b.bar = bar; b.x = xb_xcc_id(); b.st = st;
    if (threadIdx.x == 0) (void)xb_add(&bar[XB_XCNT(b.x)], 1u);
    return b;
}
__device__ __forceinline__ void xcd_barrier_complete(unsigned* bar, unsigned x, unsigned& nloc, unsigned& nx) {
    const unsigned G = gridDim.x * gridDim.y * gridDim.z;
    unsigned sum, cnt, mine, sp = 0u;
    for (;;) {
        sum = 0u; cnt = 0u; mine = 0u;
#pragma unroll
        for (unsigned j = 0; j < 16; ++j) { const unsigned c = xb_ld(&bar[XB_XCNT(j)]); sum += c; cnt += (c > 0u) ? 1u : 0u; mine = (j == x) ? c : mine; }
        if (sum == G) break;
        __builtin_amdgcn_s_sleep(1);
        if ((++sp & 255u) == 0u) { if (xb_ld(&bar[XB_TMO])) break; if (sp > XB_SPIN_CAP) { atomicAdd(&bar[XB_TMO], 1u); break; } }
    }
    nloc = mine > 0u ? mine : 1u; nx = cnt > 0u ? cnt : 1u;
}

__device__ __forceinline__ void xcd_barrier(const XcdBarrier& b) {
    asm volatile("s_waitcnt vmcnt(0)" ::: "memory");
    __syncthreads();
    if (threadIdx.x == 0) {
        unsigned* bar = b.bar;
        __builtin_amdgcn_s_waitcnt(0);
        unsigned nloc = b.st[0], nx = b.st[1];
        if (nloc == 0u) { xcd_barrier_complete(bar, b.x, nloc, nx); b.st[0] = nloc; b.st[1] = nx; }
        const unsigned old = xb_add(&bar[XB_XSUB(b.x)], 1u);
        const unsigned gen = old / nloc;
        if (old + 1u == (gen + 1u) * nloc) {
            __builtin_amdgcn_fence(__ATOMIC_RELEASE, "agent");
            asm volatile("s_waitcnt vmcnt(0)" ::: "memory");
            const unsigned og = xb_add(&bar[XB_TOP], 1u);
            const unsigned tg = og / nx;
            if (og + 1u == (tg + 1u) * nx) xb_add(&bar[XB_TOPGEN], 1u);
            else XB_SPIN(xb_ld(&bar[XB_TOPGEN]) == tg, bar);
            __builtin_amdgcn_fence(__ATOMIC_ACQUIRE, "agent");
            xb_add(&bar[XB_XGEN(b.x)], 1u);
            asm volatile("s_waitcnt vmcnt(0)" ::: "memory");
        } else {
            XB_SPIN(xb_ld(&bar[XB_XGEN(b.x)]) == gen, bar);
            __builtin_amdgcn_fence(__ATOMIC_ACQUIRE, "agent");
            asm volatile("s_waitcnt vmcnt(0)" ::: "memory");
        }
    }
    __syncthreads();
}

struct Args { const void* in[18]; float* out; unsigned char* ws; int ph_lo, ph_hi; };

#ifndef PG8_SP2
#define PG8_SP2 true
#endif
#ifndef PG8_ALIGN
#define PG8_ALIGN true
#endif
constexpr int NWAVES = 8;
constexpr int BATCH = 8, T = 4096, D = 1024, M = BATCH * T;
constexpr int NIN0 = 648, NIN0P = 768, DFF = 2816, NGU = 2 * DFF, NQQ = 2048, NHIN = 4096;
constexpr float ALPHA = 1.4142135623730951f;
constexpr float LN_EPS = 1e-5f, RMS_EPS = 1e-6f;
constexpr size_t MiB = 1u << 20;
constexpr size_t WS_CTL = 0, CTL_ZERO_BYTES = 1 * MiB;
constexpr size_t WS_W_IN0 = 2 * MiB, WS_W_Q = 4 * MiB, WS_W_O0 = 5 * MiB, WS_W_HIN = 7 * MiB, WS_W_HO = 15 * MiB;
constexpr size_t WS_W_GU0 = 17 * MiB, WS_W_DN0 = 28 * MiB, WS_W_GU1 = 34 * MiB, WS_W_DN1 = 45 * MiB;
constexpr size_t WS_COSQ = 51 * MiB, WS_SINQ = 52 * MiB, WS_COSI = 53 * MiB, WS_SINI = 55 * MiB, WS_LB = 57 * MiB;
constexpr size_t WS_RES = 60 * MiB, WS_HB = 188 * MiB;
constexpr size_t WS_CQ = 252 * MiB, WS_KVB = 268 * MiB, WS_KIDX = 284 * MiB, WS_WIDX = 292 * MiB, WS_SEL = 294 * MiB, WS_H0 = 310 * MiB, WS_QQ = 310 * MiB, WS_O = 438 * MiB;
constexpr size_t WS_SCR = WS_RES, WS_ACT = 252 * MiB, WS_HH = 252 * MiB, WS_END = 508 * MiB;
constexpr int CW_BAR = 4096;
constexpr int RING_OFF = 0, RING_BYTES = 139264;
constexpr int LDSCTL_OFF = RING_BYTES, MISC_OFF = LDSCTL_OFF + 320;
constexpr int LDS_BYTES = 147456;

typedef unsigned short u16;
typedef float f32x2 __attribute__((ext_vector_type(2)));
typedef float f32x16 __attribute__((ext_vector_type(16)));
typedef unsigned u32x2 __attribute__((ext_vector_type(2)));
typedef int i32x4 __attribute__((ext_vector_type(4)));

__device__ __forceinline__ float bf2f(unsigned h) { return __uint_as_float(h << 16); }
__device__ __forceinline__ float wave_sum(float v) {
#pragma unroll
    for (int o = 1; o < 64; o <<= 1) v += __shfl_xor(v, o);
    return v;
}
__device__ __forceinline__ int wave_sum_i(int v) {
#pragma unroll
    for (int o = 1; o < 64; o <<= 1) v += __shfl_xor(v, o);
    return v;
}
__device__ const float INVQ[8] = {1.000000000e+00f, 1.939227432e-01f, 3.760603070e-02f, 7.292664610e-03f, 1.414213562e-03f, 2.742481884e-04f, 5.318296098e-05f, 1.031338616e-05f};
__device__ const float INVI[16] = {1.000000000e+00f, 4.403665960e-01f, 1.939227432e-01f, 8.539710194e-02f, 3.760603070e-02f, 1.656043902e-02f, 7.292664610e-03f, 3.211445874e-03f,
                                   1.414213562e-03f, 6.227723788e-04f, 2.742481884e-04f, 1.207697351e-04f, 5.318296098e-05f, 2.341999971e-05f, 1.031338616e-05f, 4.541670478e-06f};

__device__ __forceinline__ void tr_item(const float* W, int K, int N, bf16* WT, int dst_row0, int k0, int n0, LAS float* scr, int lane) {
    const int n_ld = n0 + (lane & 31);
#pragma unroll 8
    for (int i = 0; i < 32; ++i) { const int kk = 2 * i + (lane >> 5); scr[kk * 33 + (lane & 31)] = (n_ld < N) ? W[(size_t)(k0 + kk) * N + n_ld] : 0.f; }
    LDS_WAIT(); asm volatile("" ::: "memory");
    const int c = lane & 7;
#pragma unroll
    for (int j = 0; j < 4; ++j) { const int n = (lane >> 3) + 8 * j; const LAS float* s = scr + (8 * c) * 33 + n;
        v4u o; o.x = pk2(s[0 * 33], s[1 * 33]); o.y = pk2(s[2 * 33], s[3 * 33]); o.z = pk2(s[4 * 33], s[5 * 33]); o.w = pk2(s[6 * 33], s[7 * 33]);
        *(v4u*)(WT + (size_t)(dst_row0 + n) * K + k0 + 8 * c) = o; }
    LDS_WAIT(); asm volatile("" ::: "memory");
}
__device__ __forceinline__ void tr_matrix_item(const float* W, int K, int N, bf16* WT, int row_off, bool grp, int it, LAS float* scr, int lane) {
    const int nblk = (N + 31) >> 5, kb = it / nblk, nb = it - kb * nblk, n0 = 32 * nb;
    const int dst = (grp ? ((n0 >> 7) * 256 + (n0 & 127)) : n0) + row_off;
    tr_item(W, K, N, WT, dst, 64 * kb, n0, scr, lane);
}
__device__ __forceinline__ void p0_prologue(const Args& A, unsigned char* ws, LAS unsigned char* lds, int gw, int NGW, int wave, int lane, int gtid, int NT) {
    LAS float* scr = (LAS float*)(lds + RING_OFF + wave * 16384);
    const float* w_in = (const float*)A.in[2]; const float* w_uq = (const float*)A.in[4]; const float* w_iq = (const float*)A.in[5]; const float* w_o = (const float*)A.in[8];
    const float* hw_in = (const float*)A.in[10]; const float* hw_o = (const float*)A.in[12];
    const float* wg = (const float*)A.in[13]; const float* wu = (const float*)A.in[14]; const float* wd = (const float*)A.in[15];
    constexpr int I0 = 16 * 21, I1 = 4 * 32, I3 = 16 * 32, I4 = 16 * 128, I6 = 16 * 88, I10 = 44 * 32;
    constexpr int NITEMS = I0 + 2 * I1 + I3 + I4 + I3 + 4 * I6 + 2 * I10;
    for (int it = gw; it < NITEMS; it += NGW) {
        int r = it;
        if (r < I0) { tr_matrix_item(w_in, 1024, NIN0, (bf16*)(ws + WS_W_IN0), 0, false, r, scr, lane); continue; } r -= I0;
        if (r < I1) { tr_matrix_item(w_uq, 256, 1024, (bf16*)(ws + WS_W_Q), 0, false, r, scr, lane); continue; } r -= I1;
        if (r < I1) { tr_matrix_item(w_iq, 256, 1024, (bf16*)(ws + WS_W_Q), 1024, false, r, scr, lane); continue; } r -= I1;
        if (r < I3) { tr_matrix_item(w_o, 1024, 1024, (bf16*)(ws + WS_W_O0), 0, false, r, scr, lane); continue; } r -= I3;
        if (r < I4) { tr_matrix_item(hw_in, 1024, 4096, (bf16*)(ws + WS_W_HIN), 0, false, r, scr, lane); continue; } r -= I4;
        if (r < I3) { tr_matrix_item(hw_o, 1024, 1024, (bf16*)(ws + WS_W_HO), 0, false, r, scr, lane); continue; } r -= I3;
        if (r < I6) { tr_matrix_item(wg, 1024, DFF, (bf16*)(ws + WS_W_GU0), 0, true, r, scr, lane); continue; } r -= I6;
        if (r < I6) { tr_matrix_item(wu, 1024, DFF, (bf16*)(ws + WS_W_GU0), 128, true, r, scr, lane); continue; } r -= I6;
        if (r < I6) { tr_matrix_item(wg + (size_t)1024 * DFF, 1024, DFF, (bf16*)(ws + WS_W_GU1), 0, true, r, scr, lane); continue; } r -= I6;
        if (r < I6) { tr_matrix_item(wu + (size_t)1024 * DFF, 1024, DFF, (bf16*)(ws + WS_W_GU1), 128, true, r, scr, lane); continue; } r -= I6;
        if (r < I10) { tr_matrix_item(wd, DFF, 1024, (bf16*)(ws + WS_W_DN0), 0, false, r, scr, lane); continue; } r -= I10;
        tr_matrix_item(wd + (size_t)DFF * 1024, DFF, 1024, (bf16*)(ws + WS_W_DN1), 0, false, r, scr, lane);
    }
    { v4u* z = (v4u*)(ws + WS_W_IN0 + (size_t)672 * 1024 * 2); const int nz = 96 * 1024 * 2 / 16;
      for (int i = gtid; i < nz; i += NT) z[i] = (v4u){0u, 0u, 0u, 0u}; }
    { const f32x4* x4 = (const f32x4*)A.in[0]; v4u* xb = (v4u*)(ws + WS_HB); const int n8 = M * D / 8;
      for (int i = gtid; i < n8; i += NT) { const f32x4 a = x4[2 * i], b = x4[2 * i + 1];
          v4u o; o.x = pk2(a.x, a.y); o.y = pk2(a.z, a.w); o.z = pk2(b.x, b.y); o.w = pk2(b.z, b.w); xb[i] = o; } }
    { const int* pos = (const int*)A.in[1]; float* cq = (float*)(ws + WS_COSQ); float* sq = (float*)(ws + WS_SINQ); float* ci = (float*)(ws + WS_COSI); float* si = (float*)(ws + WS_SINI);
      for (int idx = gtid; idx < M * 24; idx += NT) { const int m = idx / 24, i = idx - m * 24;
          const float inv = (i < 8) ? INVQ[i] : INVI[i - 8];
          const float ang = (float)pos[m] * inv;
          const double rev = (double)ang * 0.15915494309189535; const float fr = (float)(rev - floor(rev));
          const float c = __builtin_amdgcn_cosf(fr), s = __builtin_amdgcn_sinf(fr);
          if (i < 8) { cq[m * 8 + i] = c; sq[m * 8 + i] = s; } else { ci[m * 16 + i - 8] = c; si[m * 16 + i - 8] = s; } } }
    { const float* lbl = (const float*)A.in[9]; float* lb = (float*)(ws + WS_LB);
      for (int c = gtid; c < 1024; c += NT) lb[c] = 1.0f / (1.0f + expf(lbl[c] - lbl[1024 + c])); }
}

__device__ __forceinline__ void p2_fixup(const Args& A, unsigned char* ws, int gw, int NGW, int lane) {
    const float* H0 = (const float*)(ws + WS_H0); bf16* CQ = (bf16*)(ws + WS_CQ); bf16* KVB = (bf16*)(ws + WS_KVB); bf16* KIDX = (bf16*)(ws + WS_KIDX); float* WIDX = (float*)(ws + WS_WIDX);
    const float* cosq = (const float*)(ws + WS_COSQ); const float* sinq = (const float*)(ws + WS_SINQ); const float* cosi = (const float*)(ws + WS_COSI); const float* sini = (const float*)(ws + WS_SINI);
    const float* g_cq = (const float*)A.in[3]; const float* g_ik = (const float*)A.in[6]; const float* b_ik = (const float*)A.in[7];
    const f32x4 gc = *(const f32x4*)(g_cq + 4 * lane);
    const f32x2 gi = *(const f32x2*)(g_ik + 2 * lane), bi = *(const f32x2*)(b_ik + 2 * lane);
    for (int m = gw; m < M; m += NGW) {
        const float* h = H0 + (size_t)m * NIN0P;
        const f32x4 cqv = *(const f32x4*)(h + 4 * lane);
        f32x4 kv = *(const f32x4*)(h + 256 + 4 * lane);
        const f32x2 ki = *(const f32x2*)(h + 512 + 2 * lane);
        const float wv = (lane < 8) ? h[640 + lane] : 0.f;
        { const float ss = wave_sum((cqv.x * cqv.x + cqv.y * cqv.y) + (cqv.z * cqv.z + cqv.w * cqv.w));
          const float rs = 1.0f / sqrtf(ss * (1.0f / 256.0f) + RMS_EPS);
          u32x2 o; o.x = pk2(cqv.x * rs * gc.x, cqv.y * rs * gc.y); o.y = pk2(cqv.z * rs * gc.z, cqv.w * rs * gc.w);
          *(u32x2*)(CQ + (size_t)m * 256 + 4 * lane) = o; }
        { f32x4 ot; ot.x = __shfl_xor(kv.x, 2); ot.y = __shfl_xor(kv.y, 2); ot.z = __shfl_xor(kv.z, 2); ot.w = __shfl_xor(kv.w, 2);
          const int sub = lane & 15;
          if (lane < 32 && sub < 4) { const int i0 = 4 * (sub & 1);
              const f32x4 c = *(const f32x4*)(cosq + (size_t)m * 8 + i0), s = *(const f32x4*)(sinq + (size_t)m * 8 + i0);
              if (sub < 2) kv = kv * c - ot * s; else kv = kv * c + ot * s; }
          u32x2 o; o.x = pk2(kv.x, kv.y); o.y = pk2(kv.z, kv.w);
          *(u32x2*)(KVB + (size_t)m * 256 + 4 * lane) = o; }
        { const float mu = wave_sum(ki.x + ki.y) * (1.0f / 128.0f); const float dx = ki.x - mu, dy = ki.y - mu;
          const float var = wave_sum(dx * dx + dy * dy) * (1.0f / 128.0f); const float rstd = 1.0f / sqrtf(var + LN_EPS);
          float x = dx * rstd * gi.x + bi.x, y = dy * rstd * gi.y + bi.y;
          const float ox = __shfl_xor(x, 8), oy = __shfl_xor(y, 8);
          if (lane < 16) { const int i0 = 2 * (lane & 7);
              const f32x2 c = *(const f32x2*)(cosi + (size_t)m * 16 + i0), s = *(const f32x2*)(sini + (size_t)m * 16 + i0);
              if (lane < 8) { x = x * c.x - ox * s.x; y = y * c.y - oy * s.y; } else { x = x * c.x + ox * s.x; y = y * c.y + oy * s.y; } }
          *(unsigned*)(KIDX + (size_t)m * 128 + 2 * lane) = pk2(x, y); }
        if (lane < 8) WIDX[(size_t)m * 8 + lane] = wv * 0.03125f;
    }
}
__device__ __forceinline__ void p4_rope(unsigned char* ws, int gw, int NGW, int lane) {
    bf16* QQ = (bf16*)(ws + WS_QQ);
    const float* cosq = (const float*)(ws + WS_COSQ); const float* sinq = (const float*)(ws + WS_SINQ); const float* cosi = (const float*)(ws + WS_COSI); const float* sini = (const float*)(ws + WS_SINI);
    for (int m = gw; m < M; m += NGW) {
        bf16* q = QQ + (size_t)m * NQQ;
#pragma unroll
        for (int pp = 0; pp < 2; ++pp) { const int p = lane + 64 * pp, hh = p >> 3, i = p & 7, c1 = hh * 64 + i, c2 = c1 + 8;
            const float x1 = bf2f(q[c1]), x2 = bf2f(q[c2]), c = cosq[(size_t)m * 8 + i], s = sinq[(size_t)m * 8 + i];
            q[c1] = (bf16)f2bf(x1 * c - x2 * s); q[c2] = (bf16)f2bf(x2 * c + x1 * s); }
#pragma unroll
        for (int pp = 0; pp < 2; ++pp) { const int p = lane + 64 * pp, hh = p >> 4, i = p & 15, c1 = 1024 + hh * 128 + i, c2 = c1 + 16;
            const float x1 = bf2f(q[c1]), x2 = bf2f(q[c2]), c = cosi[(size_t)m * 16 + i], s = sini[(size_t)m * 16 + i];
            q[c1] = (bf16)f2bf(x1 * c - x2 * s); q[c2] = (bf16)f2bf(x2 * c + x1 * s); }
    }
}
__device__ __forceinline__ void ln_rows(const float* res, float* outf, bf16* hb, const float* g, const float* bt, int gw, int NGW, int lane) {
    f32x4 gv[4], bv[4];
#pragma unroll
    for (int j = 0; j < 4; ++j) { gv[j] = *(const f32x4*)(g + 4 * lane + 256 * j); bv[j] = *(const f32x4*)(bt + 4 * lane + 256 * j); }
    for (int m = gw; m < M; m += NGW) {
        const f32x4* xr = (const f32x4*)(res + (size_t)m * D) + lane;
        f32x4 v[4]; float s = 0.f;
#pragma unroll
        for (int j = 0; j < 4; ++j) { v[j] = xr[64 * j]; s += (v[j].x + v[j].y) + (v[j].z + v[j].w); }
        const float mean = wave_sum(s) * (1.f / D); float s2 = 0.f;
#pragma unroll
        for (int j = 0; j < 4; ++j) { v[j] = v[j] - mean; s2 += (v[j].x * v[j].x + v[j].y * v[j].y) + (v[j].z * v[j].z + v[j].w * v[j].w); }
        const float rstd = 1.f / sqrtf(wave_sum(s2) * (1.f / D) + LN_EPS);
        f32x4* orow = (f32x4*)(outf + (size_t)m * D) + lane;
#pragma unroll
        for (int j = 0; j < 4; ++j) { const f32x4 y = v[j] * rstd * gv[j] + bv[j]; orow[64 * j] = y;
            if (hb) { u32x2 o; o.x = pk2(y.x, y.y); o.y = pk2(y.z, y.w); *(u32x2*)(hb + (size_t)m * D + 4 * lane + 256 * j) = o; } }
    }
}
__device__ __forceinline__ void p15_gate(const Args& A, unsigned char* ws, int gw, int NGW, int lane) {
    bf16* OR = (bf16*)(ws + WS_HB); const bf16* HH = (const bf16*)(ws + WS_HH); const float* gn = (const float*)A.in[11];
    float gnv[16];
#pragma unroll
    for (int j = 0; j < 16; ++j) gnv[j] = gn[((16 * lane) & 127) + j];
    for (int m = gw; m < M; m += NGW) {
        const v4u o0 = *(const v4u*)(OR + (size_t)m * D + 16 * lane), o1 = *(const v4u*)(OR + (size_t)m * D + 16 * lane + 8);
        const v4u g0 = *(const v4u*)(HH + (size_t)m * NHIN + 3072 + 16 * lane), g1 = *(const v4u*)(HH + (size_t)m * NHIN + 3072 + 16 * lane + 8);
        float o[16], gg[16];
#pragma unroll
        for (int j = 0; j < 4; ++j) { o[2 * j] = bf2f(o0[j] & 0xffffu); o[2 * j + 1] = bf2f(o0[j] >> 16); o[8 + 2 * j] = bf2f(o1[j] & 0xffffu); o[8 + 2 * j + 1] = bf2f(o1[j] >> 16);
            gg[2 * j] = bf2f(g0[j] & 0xffffu); gg[2 * j + 1] = bf2f(g0[j] >> 16); gg[8 + 2 * j] = bf2f(g1[j] & 0xffffu); gg[8 + 2 * j + 1] = bf2f(g1[j] >> 16); }
        float ss = 0.f;
#pragma unroll
        for (int j = 0; j < 16; ++j) ss += o[j] * o[j];
        ss += __shfl_xor(ss, 1); ss += __shfl_xor(ss, 2); ss += __shfl_xor(ss, 4);
        const float rs = 1.0f / sqrtf(ss * (1.0f / 128.0f) + RMS_EPS);
        v4u w0, w1;
#pragma unroll
        for (int j = 0; j < 4; ++j) { w0[j] = pk2(o[2 * j] * rs * gnv[2 * j] * gg[2 * j], o[2 * j + 1] * rs * gnv[2 * j + 1] * gg[2 * j + 1]);
            w1[j] = pk2(o[8 + 2 * j] * rs * gnv[8 + 2 * j] * gg[8 + 2 * j], o[8 + 2 * j + 1] * rs * gnv[8 + 2 * j + 1] * gg[8 + 2 * j + 1]); }
        *(v4u*)(OR + (size_t)m * D + 16 * lane) = w0; *(v4u*)(OR + (size_t)m * D + 16 * lane + 8) = w1;
    }
}

#define MFMA32(a, b, c) __builtin_amdgcn_mfma_f32_32x32x16_bf16((a), (b), (c), 0, 0, 0)
#define MFMA16(a, b, c) __builtin_amdgcn_mfma_f32_16x16x32_bf16((a), (b), (c), 0, 0, 0)
#define BLOCK_SYNC() do { asm volatile("s_waitcnt vmcnt(0) lgkmcnt(0)" ::: "memory"); __builtin_amdgcn_s_barrier(); asm volatile("" ::: "memory"); } while (0)
#define LDS_SYNC() do { asm volatile("s_waitcnt lgkmcnt(0)" ::: "memory"); __builtin_amdgcn_s_barrier(); asm volatile("" ::: "memory"); } while (0)

#ifndef TOPK_ON
#define TOPK_ON 1
#endif
constexpr int IDX_ROWB = 272, IDX_BUF = 64 * IDX_ROWB;
__device__ __forceinline__ unsigned ord_key(float f) { const unsigned u = __float_as_uint(f); return (u & 0x80000000u) ? ~u : (u | 0x80000000u); }

__device__ __forceinline__ void topk_token(const float* srow, int t, u16* selrow, int lane) {
    const int n = t + 1;
    if (n <= 256) {
        u32x2 o; const int j = 4 * lane;
        o.x = (unsigned)((j <= t) ? j : 0) | ((unsigned)((j + 1 <= t) ? j + 1 : 0) << 16);
        o.y = (unsigned)((j + 2 <= t) ? j + 2 : 0) | ((unsigned)((j + 3 <= t) ? j + 3 : 0) << 16);
        *(u32x2*)(selrow + j) = o;
        return;
    }
    const int nch = (n + 255) >> 8;
    unsigned u[16][4];
#pragma unroll
    for (int i = 0; i < 16; ++i) {
        if (i < nch) { const f32x4 v = __builtin_nontemporal_load((const f32x4*)(srow + 256 * i + 4 * lane));
#pragma unroll
            for (int e = 0; e < 4; ++e) { const int s = 256 * i + 4 * lane + e; float f = v[e]; f = (f == 0.f) ? 0.f : f; u[i][e] = (s <= t) ? ord_key(f) : 0u; } }
        else {
#pragma unroll
            for (int e = 0; e < 4; ++e) u[i][e] = 0u; }
    }
    unsigned prefix = 0u;
#pragma unroll 1
    for (int bit = 31; bit >= 0; --bit) {
        const unsigned cand = prefix | (1u << bit); int c = 0;
#pragma unroll
        for (int i = 0; i < 16; ++i) if (i < nch) {
#pragma unroll
            for (int e = 0; e < 4; ++e) c += (u[i][e] >= cand) ? 1 : 0; }
        c = wave_sum_i(c);
        if (c >= 256) prefix = cand;
    }
    unsigned mlo = 0u, mhi = 0u; int ceq = 0;
    int sb4 = 4096 - 4 * lane; asm volatile("" : "+v"(sb4));
#pragma unroll
    for (int i = 15; i >= 0; --i)
#pragma unroll
        for (int e = 3; e >= 0; --e) { const int bit = 4 * i + e; const unsigned key = u[i][e]; const unsigned gt = (key > prefix) ? 1u : 0u; const bool eq = (key == prefix);
            if (bit < 32) mlo = (mlo << 1) | gt; else mhi = (mhi << 1) | gt;
            ceq += eq ? 1 : 0; u[i][e] = eq ? (unsigned)(sb4 - (256 * i + e)) : 0u; }
    const int cgt = wave_sum_i(__builtin_popcount(mlo) + __builtin_popcount(mhi)); ceq = wave_sum_i(ceq);
    const int need = 256 - cgt;
    unsigned p2 = 1u;
    if (ceq > need) {
        p2 = 0u;
#pragma unroll 1
        for (int bit = 12; bit >= 0; --bit) { const unsigned cand = p2 | (1u << bit); int c = 0;
#pragma unroll
            for (int i = 0; i < 16; ++i)
#pragma unroll
                for (int e = 0; e < 4; ++e) c += (u[i][e] >= cand) ? 1 : 0;
            c = wave_sum_i(c);
            if (c >= need) p2 = cand; }
    }
    unsigned elo = 0u, ehi = 0u;
#pragma unroll
    for (int i = 15; i >= 0; --i)
#pragma unroll
        for (int e = 3; e >= 0; --e) { const int bit = 4 * i + e; const unsigned sl = (u[i][e] >= p2) ? 1u : 0u; if (bit < 32) elo = (elo << 1) | sl; else ehi = (ehi << 1) | sl; }
    mlo |= elo; mhi |= ehi;
    const int cnt = __builtin_popcount(mlo) + __builtin_popcount(mhi);
    int incl = cnt;
#pragma unroll
    for (int o = 1; o < 64; o <<= 1) { const int v = __shfl_up(incl, o); if (lane >= o) incl += v; }
    int pos = incl - cnt;
    u16* wp = selrow + pos;
    while (mlo) { const int bit = __builtin_ctz(mlo); mlo &= mlo - 1u; *wp++ = (u16)(256 * (bit >> 2) + 4 * lane + (bit & 3)); }
    while (mhi) { const int bit = __builtin_ctz(mhi) + 32; mhi &= mhi - 1u; *wp++ = (u16)(256 * (bit >> 2) + 4 * lane + (bit & 3)); }
}

__device__ __forceinline__ void idx_tile(int b, int qt, const bf16* QQ, const bf16* KIDX, const float* WIDX, float* scr, u16* SEL, LAS unsigned char* lds, int tid, int wave, int lane) {
    const int t0 = 32 * qt, m0 = b * T + t0, nkt = (t0 + 32 + 63) >> 6;
    const int r = lane & 31, hi = lane >> 5;
    const int tokl = 2 * (r >> 4) + ((r >> 2) & 1), hh = 4 * ((r >> 3) & 1) + (r & 3);
    const bf16* qrow = QQ + (size_t)(m0 + 4 * wave + tokl) * NQQ + 1024 + hh * 128 + 8 * hi;
    bf16x8 qa[8];
#pragma unroll
    for (int ks = 0; ks < 8; ++ks) qa[ks] = *(const bf16x8*)(qrow + 16 * ks);
    const f32x4 wa0 = *(const f32x4*)(WIDX + (size_t)(m0 + 4 * wave + hi) * 8), wa1 = *(const f32x4*)(WIDX + (size_t)(m0 + 4 * wave + hi) * 8 + 4);
    const f32x4 wb0 = *(const f32x4*)(WIDX + (size_t)(m0 + 4 * wave + 2 + hi) * 8), wb1 = *(const f32x4*)(WIDX + (size_t)(m0 + 4 * wave + 2 + hi) * 8 + 4);
    const v4u* kg = (const v4u*)(KIDX + (size_t)(b * T) * 128);
    const int c0 = tid, c1 = tid + 512;
    const int l0 = (c0 >> 4) * IDX_ROWB + (c0 & 15) * 16, l1 = (c1 >> 4) * IDX_ROWB + (c1 & 15) * 16;
    v4u p0 = kg[c0], p1 = kg[c1];
    *(LAS v4u*)(lds + l0) = p0; *(LAS v4u*)(lds + l1) = p1;
    LDS_SYNC();
    float* s0p = scr + (size_t)(4 * wave + hi) * 4096 + r;
    float* s1p = scr + (size_t)(4 * wave + 2 + hi) * 4096 + r;
    for (int kt = 0; kt < nkt; ++kt) {
        const int buf = kt & 1;
        if (kt + 1 < nkt) { p0 = kg[(kt + 1) * 1024 + c0]; p1 = kg[(kt + 1) * 1024 + c1]; }
        const LAS unsigned char* kb = lds + buf * IDX_BUF + r * IDX_ROWB + 16 * hi;
#pragma unroll
        for (int blk = 0; blk < 2; ++blk) {
            f32x16 acc = {0.f, 0.f, 0.f, 0.f, 0.f, 0.f, 0.f, 0.f, 0.f, 0.f, 0.f, 0.f, 0.f, 0.f, 0.f, 0.f};
#pragma unroll
            for (int ks = 0; ks < 8; ++ks) { const bf16x8 kf = *(const LAS bf16x8*)(kb + blk * 32 * IDX_ROWB + 32 * ks); acc = MFMA32(qa[ks], kf, acc); }
            float sA = 0.f, sB = 0.f;
#pragma unroll
            for (int i = 0; i < 4; ++i) { sA += wa0[i] * fmaxf(acc[i], 0.f) + wa1[i] * fmaxf(acc[4 + i], 0.f); sB += wb0[i] * fmaxf(acc[8 + i], 0.f) + wb1[i] * fmaxf(acc[12 + i], 0.f); }
            s0p[kt * 64 + blk * 32] = sA; s1p[kt * 64 + blk * 32] = sB;
        }
        if (kt + 1 < nkt) { *(LAS v4u*)(lds + (buf ^ 1) * IDX_BUF + l0) = p0; *(LAS v4u*)(lds + (buf ^ 1) * IDX_BUF + l1) = p1; }
        LDS_SYNC();
    }
    BLOCK_SYNC();
#pragma unroll 1
    for (int j = 0; j < 4; ++j) { const int tl = 4 * wave + j; if (TOPK_ON) topk_token(scr + (size_t)tl * 4096, t0 + tl, SEL + (size_t)(m0 + tl) * 256, lane); }
    BLOCK_SYNC();
}
__device__ __forceinline__ void p5_index(unsigned char* ws, LAS unsigned char* lds, int tid, int wave, int lane, int vcu, int G) {
    const bf16* QQ = (const bf16*)(ws + WS_QQ); const bf16* KIDX = (const bf16*)(ws + WS_KIDX); const float* WIDX = (const float*)(ws + WS_WIDX);
    float* scr = (float*)(ws + WS_SCR) + (size_t)vcu * (32 * 4096); u16* SEL = (u16*)(ws + WS_SEL);
    for (int p = vcu; p < BATCH * 64; p += G) { const int b = p >> 6, q = p & 63;
        idx_tile(b, q, QQ, KIDX, WIDX, scr, SEL, lds, tid, wave, lane);
        idx_tile(b, 127 - q, QQ, KIDX, WIDX, scr, SEL, lds, tid, wave, lane); }
}

constexpr int ATT_WAVE_LDS = 17408;
typedef short s16x4 __attribute__((ext_vector_type(4)));
__device__ __forceinline__ void glds16(const void* gsrc, unsigned lds_dst) { unsigned keep;
    asm volatile("s_mov_b32 %0, m0\n\ts_mov_b32 m0, %2\n\ts_nop 0\n\tglobal_load_lds_dwordx4 %1, off\n\ts_mov_b32 m0, %0" : "=&s"(keep) : "v"(gsrc), "s"(lds_dst) : "memory"); }
__device__ __forceinline__ s16x4 vtr(const LAS unsigned char* p) { return __builtin_bit_cast(s16x4, __builtin_amdgcn_ds_read_tr16_b64_v4i16((LAS s16x4*)p)); }
__device__ __forceinline__ void attn_token(int m, const bf16* QQ, const bf16* KVB, const u16* SEL, bf16* O, LAS unsigned char* wl, unsigned wl_addr, int lane) {
    const int t = m & (T - 1), b = m >> 12; const int n = (t + 1 < 256) ? t + 1 : 256;
    LAS int* sel_l = (LAS int*)wl;
    { const u32x2 sv = *(const u32x2*)(SEL + (size_t)m * 256 + 4 * lane); const int j = 4 * lane;
      i32x4 o; o.x = (j < n) ? (int)(sv.x & 0xffffu) : 0; o.y = (j + 1 < n) ? (int)(sv.x >> 16) : 0; o.z = (j + 2 < n) ? (int)(sv.y & 0xffffu) : 0; o.w = (j + 3 < n) ? (int)(sv.y >> 16) : 0;
      *(LAS i32x4*)(sel_l + j) = o; }
    LDS_WAIT(); asm volatile("" ::: "memory");
    const int fr = lane & 15, fq = lane >> 4;
    const bf16* kvb = KVB + (size_t)(b * T) * 256;
    const int drow = lane >> 3, dcd = (((((lane & 7) >> 1) ^ fq) << 1) | (lane & 1)) * 16;
    const int q4 = fr >> 2, pp = fr & 3, rl = 4 * fq + q4, rsw = (rl >> 1) & 3;
    const LAS unsigned char* trb = wl + 1024 + rl * 128 + 8 * pp;
#pragma unroll 1
    for (int g = 0; g < 2; ++g) {
        const unsigned char* vbytes = (const unsigned char*)kvb + 256 + g * 128 + dcd;
#define ATT_DMA(c) do { _Pragma("unroll") for (int i_ = 0; i_ < 4; ++i_) { const int s_ = sel_l[32 * (c) + 8 * i_ + drow]; \
        glds16(vbytes + (size_t)s_ * 512, wl_addr + 1024u + (unsigned)(((c) & 3) * 4096 + i_ * 1024)); } } while (0)
        ATT_DMA(0); ATT_DMA(1); ATT_DMA(2); ATT_DMA(3);
        bf16x8 qf0 = {0, 0, 0, 0, 0, 0, 0, 0}, qf1 = {0, 0, 0, 0, 0, 0, 0, 0};
        if (fr < 8) { const bf16* qp = QQ + (size_t)m * NQQ + (8 * g + fr) * 64 + 8 * fq; qf0 = *(const bf16x8*)qp; qf1 = *(const bf16x8*)(qp + 32); }
        f32x4 sa[16];
        const bf16* kg = kvb + g * 64 + 8 * fq;
        bf16x8 ka[4][2], kb[4][2];
#define ATT_KLOAD(dst, grp) do { _Pragma("unroll") for (int i_ = 0; i_ < 4; ++i_) { const bf16* kr_ = kg + (size_t)sel_l[((grp) * 4 + i_) * 16 + fr] * 256; dst[i_][0] = *(const bf16x8*)kr_; dst[i_][1] = *(const bf16x8*)(kr_ + 32); } } while (0)
#define ATT_KMMA(src, grp) do { _Pragma("unroll") for (int i_ = 0; i_ < 4; ++i_) { f32x4 a_ = {0.f, 0.f, 0.f, 0.f}; a_ = MFMA16(src[i_][0], qf0, a_); a_ = MFMA16(src[i_][1], qf1, a_); sa[(grp) * 4 + i_] = a_; } } while (0)
        ATT_KLOAD(ka, 0); asm volatile("" ::: "memory");
        ATT_KLOAD(kb, 1); asm volatile("" ::: "memory");
        ATT_KMMA(ka, 0);
        ATT_KLOAD(ka, 2); asm volatile("" ::: "memory");
        ATT_KMMA(kb, 1);
        ATT_KLOAD(kb, 3); asm volatile("" ::: "memory");
        ATT_KMMA(ka, 2);
        ATT_KMMA(kb, 3);
#undef ATT_KLOAD
#undef ATT_KMMA
        float mx = -INFINITY;
#pragma unroll
        for (int tile = 0; tile < 16; ++tile)
#pragma unroll
            for (int e = 0; e < 4; ++e) { const int j = tile * 16 + 4 * fq + e; const float v = (j < n) ? sa[tile][e] * 0.125f : -INFINITY; sa[tile][e] = v; mx = fmaxf(mx, v); }
        mx = fmaxf(mx, __shfl_xor(mx, 16)); mx = fmaxf(mx, __shfl_xor(mx, 32));
        float sum = 0.f;
#pragma unroll
        for (int tile = 0; tile < 16; ++tile)
#pragma unroll
            for (int e = 0; e < 4; ++e) { const float pv = __expf(sa[tile][e] - mx); sa[tile][e] = pv; sum += pv; }
        sum += __shfl_xor(sum, 16); sum += __shfl_xor(sum, 32);
        const float inv = 1.0f / sum;
        bf16x8 P[8];
#pragma unroll
        for (int ks = 0; ks < 8; ++ks) { const f32x4 a = sa[2 * ks], c = sa[2 * ks + 1];
            const v4u w = {pk2(a[0], a[1]), pk2(a[2], a[3]), pk2(c[0], c[1]), pk2(c[2], c[3])}; P[ks] = __builtin_bit_cast(bf16x8, w); }
        f32x4 og[4];
#pragma unroll
        for (int db = 0; db < 4; ++db) og[db] = (f32x4){0.f, 0.f, 0.f, 0.f};
#pragma unroll
        for (int c = 0; c < 8; ++c) {
            if (c <= 4) asm volatile("s_waitcnt vmcnt(12)" ::: "memory"); else if (c == 5) asm volatile("s_waitcnt vmcnt(8)" ::: "memory");
            else if (c == 6) asm volatile("s_waitcnt vmcnt(4)" ::: "memory"); else asm volatile("s_waitcnt vmcnt(0)" ::: "memory");
            const LAS unsigned char* tb = trb + (c & 3) * 4096;
#pragma unroll
            for (int db = 0; db < 4; ++db) { const int sw = (db ^ rsw) << 5;
                const s16x4 lo = vtr(tb + sw), hi = vtr(tb + sw + 2048);
                const bf16x8 vf = {lo[0], lo[1], lo[2], lo[3], hi[0], hi[1], hi[2], hi[3]};
                og[db] = MFMA16(vf, P[c], og[db]); }
            if (c + 4 < 8) { LDS_WAIT(); asm volatile("" ::: "memory"); ATT_DMA(c + 4); }
        }
#undef ATT_DMA
        if (fr < 8) {
#pragma unroll
            for (int db = 0; db < 4; ++db) { const f32x4 v = og[db] * inv;
                *(u32x2*)(O + (size_t)m * D + (8 * g + fr) * 64 + 16 * db + 4 * fq) = (u32x2){pk2(v[0], v[1]), pk2(v[2], v[3])}; }
        }
        LDS_WAIT(); asm volatile("" ::: "memory");
    }
}

constexpr int HG_QT = 0, HG_KT = 17408, HG_QH = 34816, HG_KHT = 52224, HG_VT = 70656, HG_AL = 75264, HG_ST = 84480, HG_DV = 101888, HG_TOT = 102400;
__device__ __forceinline__ void hgrn_item(int item, const bf16* HH, bf16* ORAW, LAS unsigned char* lds, int tid, int wave, int lane) {
    const int b = item >> 5, h = (item >> 2) & 7, vs = item & 3;
    const int kp = lane, rq = wave;
    const bf16* qp = HH + (size_t)(b * T) * NHIN + h * 128 + 2 * kp;
    const int vrow = tid >> 3, v4 = (tid & 7) * 4;
    const bf16* vp = HH + (size_t)(b * T) * NHIN + 2048 + h * 128 + vs * 32 + v4;
    for (int i = tid; i < 2 * 8704 / 4; i += 512) ((LAS unsigned*)(lds + HG_ST))[i] = 0u;
    f32x16 accS = {0.f, 0.f, 0.f, 0.f, 0.f, 0.f, 0.f, 0.f, 0.f, 0.f, 0.f, 0.f, 0.f, 0.f, 0.f, 0.f};
    const int r = lane & 31, hi = lane >> 5;
    unsigned qw[8], fw[8]; u32x2 vw;
#pragma unroll
    for (int i = 0; i < 8; ++i) { const bf16* p = qp + (size_t)(8 * rq + i) * NHIN; qw[i] = *(const unsigned*)p; fw[i] = *(const unsigned*)(p + 1024); }
    vw = *(const u32x2*)(vp + (size_t)vrow * NHIN);
    LDS_SYNC();
#pragma unroll 1
    for (int c = 0; c < 64; ++c) {
        unsigned qc[8], fc[8]; const u32x2 vc = vw;
#pragma unroll
        for (int i = 0; i < 8; ++i) { qc[i] = qw[i]; fc[i] = fw[i]; }
        if (c + 1 < 64) {
#pragma unroll
            for (int i = 0; i < 8; ++i) { const bf16* p = qp + (size_t)(64 * (c + 1) + 8 * rq + i) * NHIN; qw[i] = *(const unsigned*)p; fw[i] = *(const unsigned*)(p + 1024); }
            vw = *(const u32x2*)(vp + (size_t)(64 * (c + 1) + vrow) * NHIN);
        }
        float b0[8], b1[8]; float r0 = 0.f, r1 = 0.f;
#pragma unroll
        for (int i = 0; i < 8; ++i) { r0 += bf2f(fc[i] & 0xffffu); r1 += bf2f(fc[i] >> 16); b0[i] = r0; b1[i] = r1; }
        *(LAS f32x2*)(lds + HG_TOT + (rq * 128 + 2 * kp) * 4) = (f32x2){r0, r1};
        { LAS u16* vt = (LAS u16*)(lds + HG_VT);
          vt[(v4 + 0) * 72 + vrow] = (u16)(vc.x & 0xffffu); vt[(v4 + 1) * 72 + vrow] = (u16)(vc.x >> 16); vt[(v4 + 2) * 72 + vrow] = (u16)(vc.y & 0xffffu); vt[(v4 + 3) * 72 + vrow] = (u16)(vc.y >> 16); }
        LDS_SYNC();
        float pre0 = 0.f, pre1 = 0.f, ref0 = 0.f, ref1 = 0.f, last0 = 0.f, last1 = 0.f;
#pragma unroll
        for (int q = 0; q < 8; ++q) { const f32x2 tt = *(const LAS f32x2*)(lds + HG_TOT + (q * 128 + 2 * kp) * 4);
            if (q < rq) { pre0 += tt.x; pre1 += tt.y; } if (q < 4) { ref0 += tt.x; ref1 += tt.y; } last0 += tt.x; last1 += tt.y; }
        unsigned kh0[4], kh1[4];
#pragma unroll
        for (int i = 0; i < 8; ++i) { const int row = 8 * rq + i;
            const float bb0 = pre0 + b0[i], bb1 = pre1 + b1[i];
            const float q0 = bf2f(qc[i] & 0xffffu), q1 = bf2f(qc[i] >> 16);
            const float k0 = 1.0f - __expf(bf2f(fc[i] & 0xffffu)), k1 = 1.0f - __expf(bf2f(fc[i] >> 16));
            const float qt0 = q0 * __expf(bb0 - ref0), qt1 = q1 * __expf(bb1 - ref1);
            const float kt0 = k0 * __expf(ref0 - bb0), kt1 = k1 * __expf(ref1 - bb1);
            const float qh0 = q0 * __expf(bb0), qh1 = q1 * __expf(bb1);
            const float kk0 = k0 * __expf(last0 - bb0), kk1 = k1 * __expf(last1 - bb1);
            *(LAS unsigned*)(lds + HG_QT + row * 272 + 4 * kp) = pk2(qt0, qt1);
            *(LAS unsigned*)(lds + HG_KT + row * 272 + 4 * kp) = pk2(kt0, kt1);
            *(LAS unsigned*)(lds + HG_QH + row * 272 + 4 * kp) = pk2(qh0, qh1);
            if (i & 1) { kh0[i >> 1] |= f2bf(kk0) << 16; kh1[i >> 1] |= f2bf(kk1) << 16; } else { kh0[i >> 1] = f2bf(kk0); kh1[i >> 1] = f2bf(kk1); } }
        *(LAS v4u*)(lds + HG_KHT + (2 * kp) * 144 + 16 * rq) = (v4u){kh0[0], kh0[1], kh0[2], kh0[3]};
        *(LAS v4u*)(lds + HG_KHT + (2 * kp + 1) * 144 + 16 * rq) = (v4u){kh1[0], kh1[1], kh1[2], kh1[3]};
        if (rq == 0) *(LAS f32x2*)(lds + HG_DV + 8 * kp) = (f32x2){__expf(last0), __expf(last1)};
        LDS_SYNC();
        if (wave < 3) {
            const int sb = (wave == 2) ? 1 : 0, tb = (wave == 0) ? 0 : 1;
            f32x16 a = {0.f, 0.f, 0.f, 0.f, 0.f, 0.f, 0.f, 0.f, 0.f, 0.f, 0.f, 0.f, 0.f, 0.f, 0.f, 0.f};
#pragma unroll
            for (int ks = 0; ks < 8; ++ks) { const bf16x8 ka = *(const LAS bf16x8*)(lds + HG_KT + (32 * sb + r) * 272 + 32 * ks + 16 * hi);
                const bf16x8 qb = *(const LAS bf16x8*)(lds + HG_QT + (32 * tb + r) * 272 + 32 * ks + 16 * hi); a = MFMA32(ka, qb, a); }
#pragma unroll
            for (int g4 = 0; g4 < 4; ++g4) { float v[4];
#pragma unroll
                for (int e = 0; e < 4; ++e) { const int sl = 8 * g4 + 4 * hi + e; v[e] = (sb != tb || sl <= r) ? a[4 * g4 + e] : 0.f; }
                *(LAS u32x2*)(lds + HG_AL + (32 * tb + r) * 144 + (32 * sb + 8 * g4 + 4 * hi) * 2) = (u32x2){pk2(v[0], v[1]), pk2(v[2], v[3])}; }
        } else if (wave >= 4) {
            const int kb = wave - 4;
#pragma unroll
            for (int i = 0; i < 16; ++i) accS[i] *= *(const LAS float*)(lds + HG_DV + (32 * kb + (i & 3) + 8 * (i >> 2) + 4 * hi) * 4);
#pragma unroll
            for (int ks = 0; ks < 4; ++ks) { const bf16x8 ka = *(const LAS bf16x8*)(lds + HG_KHT + (32 * kb + r) * 144 + 32 * ks + 16 * hi);
                const bf16x8 vb = *(const LAS bf16x8*)(lds + HG_VT + r * 144 + 32 * ks + 16 * hi); accS = MFMA32(ka, vb, accS); }
            LAS unsigned char* st = lds + HG_ST + ((c + 1) & 1) * 8704;
#pragma unroll
            for (int g4 = 0; g4 < 4; ++g4) *(LAS u32x2*)(st + r * 272 + (32 * kb + 8 * g4 + 4 * hi) * 2) = (u32x2){pk2(accS[4 * g4], accS[4 * g4 + 1]), pk2(accS[4 * g4 + 2], accS[4 * g4 + 3])};
        }
        LDS_SYNC();
        if (wave < 2) {
            const int tb = wave;
            f32x16 o = {0.f, 0.f, 0.f, 0.f, 0.f, 0.f, 0.f, 0.f, 0.f, 0.f, 0.f, 0.f, 0.f, 0.f, 0.f, 0.f};
#pragma unroll
            for (int ks = 0; ks < 4; ++ks) if (ks < 2 || tb == 1) { const bf16x8 aa = *(const LAS bf16x8*)(lds + HG_AL + (32 * tb + r) * 144 + 32 * ks + 16 * hi);
                const bf16x8 vb = *(const LAS bf16x8*)(lds + HG_VT + r * 144 + 32 * ks + 16 * hi); o = MFMA32(aa, vb, o); }
            const LAS unsigned char* st = lds + HG_ST + (c & 1) * 8704;
#pragma unroll
            for (int ks = 0; ks < 8; ++ks) { const bf16x8 aa = *(const LAS bf16x8*)(lds + HG_QH + (32 * tb + r) * 272 + 32 * ks + 16 * hi);
                const bf16x8 sb = *(const LAS bf16x8*)(st + r * 272 + 32 * ks + 16 * hi); o = MFMA32(aa, sb, o); }
            bf16* op = ORAW + (size_t)(b * T + 64 * c + 32 * tb) * D + h * 128 + vs * 32 + r;
#pragma unroll
            for (int i = 0; i < 16; ++i) op[(size_t)((i & 3) + 8 * (i >> 2) + 4 * hi) * D] = (bf16)f2bf(o[i]);
        }
        LDS_SYNC();
    }
}

__global__ void __launch_bounds__(NWAVES * 64, 2) mk_fwd(Args args) {
    extern __shared__ __attribute__((aligned(16))) unsigned char lds_raw[];
    LAS unsigned char* lds = (LAS unsigned char*)lds_raw;
    const unsigned lds0 = (unsigned)(uintptr_t)lds_raw;
    volatile LAS unsigned* MISC = (volatile LAS unsigned*)(lds + MISC_OFF);
    const int tid = threadIdx.x, lane = tid & 63, wave = __builtin_amdgcn_readfirstlane(tid >> 6);
    const int G = gridDim.x; const int bx = blockIdx.x; const int vcu = (G % 8 == 0) ? (bx % 8) * (G / 8) + bx / 8 : bx;
    const int gw = vcu * NWAVES + wave, NGW = G * NWAVES, gtid = vcu * (NWAVES * 64) + tid, NT = G * NWAVES * 64;
    unsigned char* ws = args.ws;
    gu32* ctl = (gu32*)(ws + WS_CTL);
    for (int u = tid; u < (LDS_BYTES - LDSCTL_OFF) / 4; u += NWAVES * 64) ((LAS unsigned*)(lds + LDSCTL_OFF))[u] = 0u;
    __syncthreads();
    XcdBarrier bar = xcd_barrier_post((unsigned*)(ctl + CW_BAR), MISC + 8);
    const int lo = args.ph_lo, hi = args.ph_hi;
#ifndef REPMASK
#define REPMASK 0u
#endif
#define REP(k) ((((REPMASK) >> (k)) & 1u) ? 2 : 1)
#ifndef PHMASK
#define PHMASK 0xFFFFFu
#endif
#define IN(k) ((((PHMASK) >> (k)) & 1u) && lo <= (k) && (k) < hi)
#define SEAM(k) do { if (IN(k) && IN((k) + 1)) xcd_barrier(bar); } while (0)
    const float* x_in = (const float*)args.in[0];
    const float* ln_g = (const float*)args.in[16]; const float* ln_b = (const float*)args.in[17];
    float* RES = (float*)(ws + WS_RES); bf16* HB = (bf16*)(ws + WS_HB);

    if (IN(0)) p0_prologue(args, ws, lds, gw, NGW, wave, lane, gtid, NT);
    SEAM(0);
    if (IN(1)) {
        pg8::Gemm g{(const bf16*)(ws + WS_HB), (const bf16*)(ws + WS_W_IN0), M, NIN0P, D}; pg8::StaticOrder S; S.init(M, NIN0P, G, bx);
        pg8::EpiF32 E{(float*)(ws + WS_H0), NIN0P};
        pg8::gemm_phase<pg8::EpiF32, pg8::StaticOrder, PG8_ALIGN, PG8_SP2>(lds + RING_OFF, g, S, E);
    }
    SEAM(1);
    if (IN(2)) p2_fixup(args, ws, gw, NGW, lane);
    SEAM(2);
    if (IN(3)) {
        pg8::Gemm g{(const bf16*)(ws + WS_CQ), (const bf16*)(ws + WS_W_Q), M, NQQ, 256}; pg8::StaticOrder S; S.init(M, NQQ, G, bx);
        pg8::EpiBf16 E{(bf16*)(ws + WS_QQ), NQQ};
        pg8::gemm_phase<pg8::EpiBf16, pg8::StaticOrder, PG8_ALIGN, PG8_SP2>(lds + RING_OFF, g, S, E);
    }
    SEAM(3);
    if (IN(4)) p4_rope(ws, gw, NGW, lane);
    SEAM(4);
    if (IN(5)) { for (int rep = 0; rep < REP(5); ++rep) p5_index(ws, lds, tid, wave, lane, vcu, G); }
    SEAM(5);
    if (IN(6)) {
        const bf16* QQ = (const bf16*)(ws + WS_QQ); const bf16* KVB = (const bf16*)(ws + WS_KVB); const u16* SEL = (const u16*)(ws + WS_SEL); bf16* O = (bf16*)(ws + WS_O);
        for (int rep = 0; rep < REP(6); ++rep) for (int m = gw; m < M; m += NGW) attn_token(m, QQ, KVB, SEL, O, lds + RING_OFF + wave * ATT_WAVE_LDS, (unsigned)__builtin_amdgcn_readfirstlane((int)(lds0 + RING_OFF + wave * ATT_WAVE_LDS)), lane);
    }
    SEAM(6);
    if (IN(7)) {
        pg8::Gemm g{(const bf16*)(ws + WS_O), (const bf16*)(ws + WS_W_O0), M, D, D}; pg8::StaticOrder S; S.init(M, D, G, bx);
        pg8::EpiRes E{x_in, RES, D, ALPHA};
        pg8::gemm_phase<pg8::EpiRes, pg8::StaticOrder, PG8_ALIGN, PG8_SP2>(lds + RING_OFF, g, S, E);
    }
    SEAM(7);
    if (IN(8)) ln_rows(RES, RES, HB, ln_g, ln_b, gw, NGW, lane);
    SEAM(8);
    if (IN(9)) {
        pg8::Gemm g{HB, (const bf16*)(ws + WS_W_GU0), M, NGU, D}; pg8::StaticOrder S; S.init(M, NGU, G, bx);
        pg8::EpiSwiGLU E{(bf16*)(ws + WS_ACT), DFF};
        pg8::gemm_phase<pg8::EpiSwiGLU, pg8::StaticOrder, PG8_ALIGN, PG8_SP2>(lds + RING_OFF, g, S, E);
    }
    SEAM(9);
    if (IN(10)) {
        pg8::Gemm g{(const bf16*)(ws + WS_ACT), (const bf16*)(ws + WS_W_DN0), M, D, DFF}; pg8::StaticOrder S; S.init(M, D, G, bx);
        pg8::EpiRes E{RES, RES, D, ALPHA};
        pg8::gemm_phase<pg8::EpiRes, pg8::StaticOrder, PG8_ALIGN, PG8_SP2>(lds + RING_OFF, g, S, E);
    }
    SEAM(10);
    if (IN(11)) ln_rows(RES, RES, HB, ln_g + D, ln_b + D, gw, NGW, lane);
    SEAM(11);
    if (IN(12)) {
        pg8::Gemm g{HB, (const bf16*)(ws + WS_W_HIN), M, NHIN, D}; pg8::StaticOrder S; S.init(M, NHIN, G, bx);
        pg8::EpiHgrnIn E{(bf16*)(ws + WS_HH), NHIN, (const float*)(ws + WS_LB)};
        pg8::gemm_phase<pg8::EpiHgrnIn, pg8::StaticOrder, PG8_ALIGN, PG8_SP2>(lds + RING_OFF, g, S, E);
    }
    SEAM(12);
    if (IN(13)) { for (int rep = 0; rep < REP(13); ++rep) for (int item = vcu; item < 256; item += G) hgrn_item(item, (const bf16*)(ws + WS_HH), HB, lds + RING_OFF, tid, wave, lane); }
    SEAM(13);
    if (IN(14)) p15_gate(args, ws, gw, NGW, lane);
    SEAM(14);
    if (IN(15)) {
        pg8::Gemm g{HB, (const bf16*)(ws + WS_W_HO), M, D, D}; pg8::StaticOrder S; S.init(M, D, G, bx);
        pg8::EpiRes E{RES, RES, D, ALPHA};
        pg8::gemm_phase<pg8::EpiRes, pg8::StaticOrder, PG8_ALIGN, PG8_SP2>(lds + RING_OFF, g, S, E);
    }
    SEAM(15);
    if (IN(16)) ln_rows(RES, RES, HB, ln_g + 2 * D, ln_b + 2 * D, gw, NGW, lane);
    SEAM(16);
    if (IN(17)) {
        pg8::Gemm g{HB, (const bf16*)(ws + WS_W_GU1), M, NGU, D}; pg8::StaticOrder S; S.init(M, NGU, G, bx);
        pg8::EpiSwiGLU E{(bf16*)(ws + WS_ACT), DFF};
        pg8::gemm_phase<pg8::EpiSwiGLU, pg8::StaticOrder, PG8_ALIGN, PG8_SP2>(lds + RING_OFF, g, S, E);
    }
    SEAM(17);
    if (IN(18)) {
        pg8::Gemm g{(const bf16*)(ws + WS_ACT), (const bf16*)(ws + WS_W_DN1), M, D, DFF}; pg8::StaticOrder S; S.init(M, D, G, bx);
        pg8::EpiRes E{RES, RES, D, ALPHA};
        pg8::gemm_phase<pg8::EpiRes, pg8::StaticOrder, PG8_ALIGN, PG8_SP2>(lds + RING_OFF, g, S, E);
    }
    SEAM(18);
    if (IN(19)) ln_rows(RES, args.out, nullptr, ln_g + 3 * D, ln_b + 3 * D, gw, NGW, lane);
#undef IN
#undef SEAM
}

extern "C" void kernel_launch(void* const* d_in, const int* in_sizes, int n_in, void* d_out, int out_size, void* d_ws, size_t ws_size, hipStream_t stream) {
    static int grid = 0;
    if (grid == 0) {
        if (n_in != 18 || in_sizes[0] != M * D || out_size != M * D || ws_size < WS_END) { fprintf(stderr, "kernel_launch: unexpected shapes (n_in %d, in0 %d, out %d, ws %zu)\n", n_in, n_in > 0 ? in_sizes[0] : -1, out_size, ws_size); grid = -1; return; }
        int dev = 0, cus = 0;
        if (hipGetDevice(&dev) != hipSuccess || hipDeviceGetAttribute(&cus, hipDeviceAttributeMultiprocessorCount, dev) != hipSuccess) { grid = -1; return; }
        if (hipFuncSetAttribute((const void*)mk_fwd, hipFuncAttributeMaxDynamicSharedMemorySize, LDS_BYTES) != hipSuccess) { fprintf(stderr, "kernel_launch: hipFuncSetAttribute failed\n"); grid = -1; return; }
        int per_cu = 0;
        if (hipOccupancyMaxActiveBlocksPerMultiprocessor(&per_cu, (const void*)mk_fwd, NWAVES * 64, LDS_BYTES) != hipSuccess || per_cu < 1) fprintf(stderr, "kernel_launch: occupancy query says %d\n", per_cu);
        (void)hipGetLastError();
        grid = cus;
    }
    if (grid < 0) return;
    if (hipMemsetAsync((char*)d_ws + WS_CTL, 0, CTL_ZERO_BYTES, stream) != hipSuccess) return;
    Args a{};
    for (int i = 0; i < 18; ++i) a.in[i] = d_in[i];
    a.out = (float*)d_out; a.ws = (unsigned char*)d_ws;
#ifndef MK_CUTS
    a.ph_lo = 0; a.ph_hi = 20;
    hipLaunchKernelGGL(mk_fwd, dim3(grid), dim3(NWAVES * 64), LDS_BYTES, stream, a);
#else
    for (int p = 0; p < 20; ++p) { a.ph_lo = p; a.ph_hi = p + 1; hipLaunchKernelGGL(mk_fwd, dim3(grid), dim3(NWAVES * 64), LDS_BYTES, stream, a); }
#endif
}
```
